# Optimizing an MI355X kernel written in HIP

```python
import jax
import jax.numpy as jnp
from jax import lax
import numpy as np

D_MODEL = 1024
BATCH = 8
SEQ = 4096
DEPTH = 1

ATT_HEADS = 8
ATT_KV_HEADS = 2
ATT_GROUP = ATT_HEADS // ATT_KV_HEADS
ATT_HEAD_DIM = 64
WINDOW = 128
ATT_BLOCK = 128
ROPE_DIM = ATT_HEAD_DIM // 4
ROPE_THETA = 500000.0

RET_HEADS = 4
RET_KEY_DIM = 128
RET_VAL_DIM = 256
RET_CHUNK = 128
RET_ROT_BASE = 10000.0

D_FF = 4 * D_MODEL

NORM_EPS = 1e-6
GN_EPS = 1e-6
NEG_INF = -1e30

ATT_Q_W = ATT_HEADS * ATT_HEAD_DIM
ATT_KV_W = ATT_KV_HEADS * ATT_HEAD_DIM
RET_QK_W = RET_HEADS * RET_KEY_DIM
RET_V_W = RET_HEADS * RET_VAL_DIM
IN_SPLITS = (ATT_Q_W, ATT_KV_W, ATT_KV_W, RET_QK_W, RET_QK_W, RET_V_W, RET_V_W, D_MODEL, D_MODEL)
IN_WIDTH = sum(IN_SPLITS)
IN_OFFSETS = tuple(int(v) for v in np.cumsum(IN_SPLITS)[:-1])

kernel_name = "hybrid_swa_sink_retention_gated_block"


def rmsnorm(x, gain):
    xf = x.astype(jnp.float32)
    y = xf * lax.rsqrt(jnp.mean(xf * xf, axis=-1, keepdims=True) + NORM_EPS)
    return (y * gain.astype(jnp.float32)).astype(x.dtype)


def rope_tables(seq_len, dim, theta):
    pos = jnp.arange(seq_len, dtype=jnp.float32)
    inv_freq = theta ** (-jnp.arange(0, dim, 2, dtype=jnp.float32) / dim)
    ang = pos[:, None] * inv_freq[None, :]
    return jnp.cos(ang)[:, None, :], jnp.sin(ang)[:, None, :]


def apply_rope(x, cos, sin):
    xf = x.astype(jnp.float32)
    x1, x2 = jnp.split(xf, 2, axis=-1)
    out = jnp.concatenate([x1 * cos - x2 * sin, x2 * cos + x1 * sin], axis=-1)
    return out.astype(x.dtype)


def partial_rope(x, cos, sin):
    return jnp.concatenate([apply_rope(x[..., :ROPE_DIM], cos, sin), x[..., ROPE_DIM:]], axis=-1)


def sliding_window_sink_attention(q, k, v, sinks):
    b, s, _, dh = q.shape
    c = ATT_BLOCK
    nb = s // c
    qb = q.reshape(b, nb, c, ATT_KV_HEADS, ATT_GROUP, dh)
    kb = k.reshape(b, nb, c, ATT_KV_HEADS, dh)
    vb = v.reshape(b, nb, c, ATT_KV_HEADS, dh)

    def with_prev(t):
        prev = jnp.concatenate([jnp.zeros_like(t[:, :1]), t[:, :-1]], axis=1)
        return jnp.concatenate([prev, t], axis=2)

    kw, vw = with_prev(kb), with_prev(vb)
    scores = jnp.einsum('bnqhgd,bnkhd->bnhgqk', qb, kw,
                        preferred_element_type=jnp.float32) * (dh ** -0.5)
    qi = jnp.arange(c)[:, None] + c
    kj = jnp.arange(2 * c)[None, :]
    delta = qi - kj
    in_window = (delta >= 0) & (delta < WINDOW)
    has_prev = (jnp.arange(nb) > 0)[:, None, None] | (kj >= c)[None]
    mask = in_window[None] & has_prev
    scores = jnp.where(mask[None, :, None, None], scores, NEG_INF)
    sink = sinks.astype(jnp.float32).reshape(ATT_KV_HEADS, ATT_GROUP)[None, None, :, :, None, None]
    sink = jnp.broadcast_to(sink, scores.shape[:-1] + (1,))
    probs = jax.nn.softmax(jnp.concatenate([scores, sink], axis=-1), axis=-1)[..., :-1]
    out = jnp.einsum('bnhgqk,bnkhd->bnqhgd', probs.astype(v.dtype), vw)
    return out.reshape(b, s, ATT_HEADS * dh)


def chunkwise_retention(q, k, v):
    b, s, h, dk = q.shape
    dv = v.shape[-1]
    c = RET_CHUNK
    nc = s // c
    log_gamma = jnp.log1p(-jnp.exp2(-5.0 - jnp.arange(h, dtype=jnp.float32)))
    idx = jnp.arange(c, dtype=jnp.float32)
    diff = idx[:, None] - idx[None, :]
    intra = jnp.where(diff >= 0, jnp.exp(jnp.maximum(diff, 0.0) * log_gamma[:, None, None]), 0.0)
    q_decay = jnp.exp((idx + 1.0)[None, :] * log_gamma[:, None])[..., None]
    k_decay = jnp.exp((c - 1.0 - idx)[None, :] * log_gamma[:, None])[..., None]
    chunk_decay = jnp.exp(c * log_gamma)[:, None, None]

    def to_chunks(t):
        return t.astype(jnp.float32).reshape(b, nc, c, h, t.shape[-1]).transpose(1, 0, 3, 2, 4)

    qc, kc, vc = to_chunks(q), to_chunks(k), to_chunks(v)

    def step(state, inp):
        qi, ki, vi = inp
        att = jnp.einsum('bhqd,bhkd->bhqk', qi, ki) * intra
        inner = jnp.einsum('bhqk,bhkv->bhqv', att, vi)
        cross = jnp.einsum('bhqd,bhdv->bhqv', qi * q_decay, state)
        new_state = state * chunk_decay + jnp.einsum('bhkd,bhkv->bhdv', ki * k_decay, vi)
        return new_state, inner + cross

    state0 = jnp.zeros((b, h, dk, dv), jnp.float32)
    _, out = lax.scan(step, state0, (qc, kc, vc))
    return out.transpose(1, 0, 3, 2, 4).reshape(b, s, h, dv)


def head_groupnorm(y, gain):
    b, s, h, dv = y.shape
    mu = jnp.mean(y, axis=-1, keepdims=True)
    var = jnp.mean(jnp.square(y - mu), axis=-1, keepdims=True)
    yn = (y - mu) * lax.rsqrt(var + GN_EPS)
    return yn.reshape(b, s, h * dv) * gain.astype(jnp.float32)


def mixer_block(xn, w_in, b_gates, attn_sinks, ret_gn_gain, w_att_up, w_ret_up, w_out, att_rope, ret_rope):
    b, s, _ = xn.shape
    proj = jnp.einsum('bsd,dn->bsn', xn, w_in)
    q_a, k_a, v_a, q_r, k_r, v_r, g_r, gate_a, gate_r = jnp.split(proj, IN_OFFSETS, axis=-1)

    q_a = partial_rope(q_a.reshape(b, s, ATT_HEADS, ATT_HEAD_DIM), *att_rope)
    k_a = partial_rope(k_a.reshape(b, s, ATT_KV_HEADS, ATT_HEAD_DIM), *att_rope)
    v_a = v_a.reshape(b, s, ATT_KV_HEADS, ATT_HEAD_DIM)
    y_a = sliding_window_sink_attention(q_a, k_a, v_a, attn_sinks) @ w_att_up

    q_r = apply_rope(q_r.reshape(b, s, RET_HEADS, RET_KEY_DIM), *ret_rope)
    k_r = apply_rope(k_r.reshape(b, s, RET_HEADS, RET_KEY_DIM), *ret_rope) * (RET_KEY_DIM ** -0.5)
    ret = chunkwise_retention(q_r, k_r, v_r.reshape(b, s, RET_HEADS, RET_VAL_DIM))
    ret = head_groupnorm(ret, ret_gn_gain)
    y_r = (jax.nn.silu(g_r.astype(jnp.float32)) * ret).astype(xn.dtype) @ w_ret_up

    bg = b_gates.astype(jnp.float32)
    ga = jax.nn.sigmoid(gate_a.astype(jnp.float32) + bg[:D_MODEL])
    gr = jax.nn.sigmoid(gate_r.astype(jnp.float32) + bg[D_MODEL:])
    merged = (ga * y_a.astype(jnp.float32) + gr * y_r.astype(jnp.float32)).astype(xn.dtype)
    return merged @ w_out


def squared_relu_mlp(xn, w_ff1, w_ff2):
    hdn = jnp.square(jax.nn.relu(xn @ w_ff1))
    return hdn @ w_ff2


def setup_inputs(seed: int = 0) -> dict:
    key = jax.random.key(seed)
    ks = jax.random.split(key, 14)
    f32 = jnp.float32

    def normal(k, shape, scale):
        return jax.random.normal(k, shape, f32) * scale

    def gain(k, shape):
        return 1.0 + 0.02 * jax.random.normal(k, shape, f32)

    return {
        'x': normal(ks[0], (BATCH, SEQ, D_MODEL), 1.0),
        'norm_mix_gain': gain(ks[1], (DEPTH, D_MODEL)),
        'w_in': normal(ks[2], (DEPTH, D_MODEL, IN_WIDTH), D_MODEL ** -0.5),
        'b_gates': normal(ks[3], (DEPTH, 2 * D_MODEL), 0.1),
        'attn_sinks': normal(ks[4], (DEPTH, ATT_HEADS), 0.5),
        'ret_gn_gain': gain(ks[5], (DEPTH, RET_V_W)),
        'w_att_up': normal(ks[6], (DEPTH, ATT_Q_W, D_MODEL), ATT_Q_W ** -0.5),
        'w_ret_up': normal(ks[7], (DEPTH, RET_V_W, D_MODEL), RET_V_W ** -0.5),
        'w_out': normal(ks[8], (DEPTH, D_MODEL, D_MODEL), D_MODEL ** -0.5),
        'norm_mlp_gain': gain(ks[9], (DEPTH, D_MODEL)),
        'w_ff1': normal(ks[10], (DEPTH, D_MODEL, D_FF), D_MODEL ** -0.5),
        'w_ff2': normal(ks[11], (DEPTH, D_FF, D_MODEL), D_FF ** -0.5),
        'norm_final_gain': gain(ks[12], (D_MODEL,)),
    }


def reference(x, norm_mix_gain, w_in, b_gates, attn_sinks, ret_gn_gain, w_att_up, w_ret_up, w_out,
              norm_mlp_gain, w_ff1, w_ff2, norm_final_gain):
    s = x.shape[1]
    att_rope = rope_tables(s, ROPE_DIM, ROPE_THETA)
    ret_rope = rope_tables(s, RET_KEY_DIM, RET_ROT_BASE)
    h = x
    for l in range(DEPTH):
        h = h + mixer_block(rmsnorm(h, norm_mix_gain[l]), w_in[l], b_gates[l], attn_sinks[l],
                            ret_gn_gain[l], w_att_up[l], w_ret_up[l], w_out[l], att_rope, ret_rope)
        h = h + squared_relu_mlp(rmsnorm(h, norm_mlp_gain[l]), w_ff1[l], w_ff2[l])
    return rmsnorm(h, norm_final_gain)
```

```cpp
#include <hip/hip_runtime.h>
#include <hip/hip_cooperative_groups.h>
#include <cstdio>
#include <cstdint>
namespace cg = cooperative_groups;
namespace pg8 {
#define PG8_LAS __attribute__((address_space(3)))
typedef unsigned short bf16_t;
typedef short bf16x8 __attribute__((ext_vector_type(8)));
typedef float f32x4 __attribute__((ext_vector_type(4)));
typedef unsigned u32x4 __attribute__((ext_vector_type(4)));
constexpr int BM = 256, BK = 64, HALF = 128, HTB = HALF * BK * 2  , STAGE_BYTES = 8 * HTB, NXCD = 8, WGM = 8;

__host__ __device__ __forceinline__ int lds_byte(int r, int c) { const int st = (r >> 4) * 2 + (c >> 5), rr = r & 15, cc = c & 31, ob = rr * 64 + cc * 2; return st * 1024 + (ob ^ (((ob >> 9) & 1) << 5)); }
__host__ __device__ __forceinline__ void stage_rc(int b, int& R, int& C) { const int st = b / 1024, sb = b % 1024, swz = sb ^ (((sb >> 9) & 1) << 5); R = (st >> 1) * 16 + swz / 64; C = (st & 1) * 32 + (swz % 64) / 2; }
__host__ __device__ __forceinline__ int perm32(int rho) { const int n = rho >> 4, i = rho & 15; return 8 * (i >> 2) + 4 * n + (i & 3); }

struct Unit { int pm, pn; };
struct Gemm { const bf16_t* A; const bf16_t* Bt; int M, N, K, lda; };

struct StaticOrder {
    int nM, nN, nwg, G, c;
    __host__ __device__ void init(int M, int N, int G_, int c_) { nM = M / BM; nN = N / BM; nwg = nM * nN; G = G_; c = c_; }
    __host__ __device__ bool next(int i, Unit& u) const {
        const long L = (long)i * G + c; if (L >= nwg) return false;
        int wgid = (int)L; { const int q = nwg / NXCD, r = nwg % NXCD, xcd = wgid % NXCD, off = wgid / NXCD; wgid = (xcd < r ? xcd * (q + 1) : r * (q + 1) + (xcd - r) * q) + off; }
        const int nig = WGM * nN, gid = wgid / nig, fm = gid * WGM, gsz = (nM - fm) < WGM ? (nM - fm) : WGM;
        u.pm = fm + ((wgid % nig) % gsz); u.pn = (wgid % nig) / gsz; return true;
    }
    __device__ __forceinline__ void a_ready(const Unit&) const {}
    __device__ __forceinline__ void done(const Unit&) const {}
};

__device__ __forceinline__ unsigned pk2(float lo, float hi) { typedef float f2_t __attribute__((ext_vector_type(2))); typedef __bf16 b2_t __attribute__((ext_vector_type(2))); f2_t v = {lo, hi}; b2_t b = __builtin_convertvector(v, b2_t); return __builtin_bit_cast(unsigned, b); }
__device__ __forceinline__ float bflo(unsigned w) { return __uint_as_float(w << 16); }
__device__ __forceinline__ float bfhi(unsigned w) { return __uint_as_float(w & 0xffff0000u); }
__device__ __forceinline__ u32x4 pack8(const f32x4 v0, const f32x4 v1) { u32x4 w; w.x = pk2(v0[0], v0[1]); w.y = pk2(v0[2], v0[3]); w.z = pk2(v1[0], v1[1]); w.w = pk2(v1[2], v1[3]); return w; }
__device__ __forceinline__ float sigmoidf_(float v) { return __builtin_amdgcn_rcpf(1.0f + __expf(-v)); }

constexpr int PW = 5888;
constexpr size_t MROWS = 32768;
struct EpiProj {
    static constexpr bool PERM = true, AFTER_DRAIN = false;
    bf16_t* O; const float* bg; const float* tabA; const float* tabR;
    template <int TYPE, int cs, int ws> __device__ __forceinline__ void half(const f32x4 (&acc)[2][2][4][2], int bj, int row0, int col0) const {
        f32x4 b0 = (f32x4){0.f, 0.f, 0.f, 0.f}, b1 = b0;
        if (TYPE == 6) { b0 = *(const f32x4*)(bg + col0 - 3840); b1 = *(const f32x4*)(bg + col0 - 3840 + 4); }
        char* const sbase = (char*)(O + MROWS * cs); const unsigned boff0 = ((unsigned)row0 * (unsigned)ws + (unsigned)(col0 - cs)) * 2u;
        const bool ropeA = (TYPE <= 1) && ((col0 & 63) < 16);
        const int gA = (col0 & 63) >> 3, gR = (col0 & 127) >> 3;
#pragma unroll
        for (int ai = 0; ai < 2; ++ai)
#pragma unroll
            for (int m = 0; m < 4; ++m) {
                const int row = row0 + ai * HALF + m * 16, pos = row & 4095;
                f32x4 v0 = acc[ai][bj][m][0], v1 = acc[ai][bj][m][1];
                if (TYPE == 0 || TYPE == 1) {
                    if (ropeA) {
                        const f32x4* t = (const f32x4*)(tabA + ((size_t)pos * 8 + gA * 4) * 2); const f32x4 t0 = t[0], t1 = t[1];
                        const f32x4 cv = (f32x4){t0[0], t0[2], t1[0], t1[2]}, sn = (f32x4){t0[1], t0[3], t1[1], t1[3]};
                        const f32x4 a = v0 * cv - v1 * sn, bb = v1 * cv + v0 * sn; v0 = a; v1 = bb;
                    }
                    if (TYPE == 0) { v0 = v0 * 0.125f; v1 = v1 * 0.125f; }
                } else if (TYPE == 3 || TYPE == 4) {
                    const f32x4* t = (const f32x4*)(tabR + ((size_t)pos * 64 + gR * 4) * 2); const f32x4 t0 = t[0], t1 = t[1];
                    const f32x4 cv = (f32x4){t0[0], t0[2], t1[0], t1[2]}, sn = (f32x4){t0[1], t0[3], t1[1], t1[3]};
                    const f32x4 a = v0 * cv - v1 * sn, bb = v1 * cv + v0 * sn; v0 = a; v1 = bb;
                    if (TYPE == 4) { v0 = v0 * 0.08838834764831845f; v1 = v1 * 0.08838834764831845f; }
                } else if (TYPE == 5) {
#pragma unroll
                    for (int e = 0; e < 4; ++e) { v0[e] = v0[e] * sigmoidf_(v0[e]); v1[e] = v1[e] * sigmoidf_(v1[e]); }
                } else if (TYPE == 6) {
#pragma unroll
                    for (int e = 0; e < 4; ++e) { v0[e] = sigmoidf_(v0[e] + b0[e]); v1[e] = sigmoidf_(v1[e] + b1[e]); }
                }
                *(u32x4*)(sbase + (boff0 + (unsigned)((ai * HALF + m * 16) * ws * 2))) = pack8(v0, v1);
            }
    }
    __device__ __forceinline__ void operator()(const f32x4 (&acc)[2][2][4][2], const Unit& u, int wr, int wc, int fr, int fq) const {
        const int row0 = u.pm * BM + wr * 64 + fr;
#pragma unroll
        for (int bj = 0; bj < 2; ++bj) {
            const int colbase = u.pn * BM + bj * HALF, sec = colbase >> 7, col0 = colbase + wc * 32 + 8 * fq;
            if (sec < 4) half<0, 0, 512>(acc, bj, row0, col0);
            else if (sec == 4) half<1, 512, 128>(acc, bj, row0, col0);
            else if (sec == 5) half<2, 640, 128>(acc, bj, row0, col0);
            else if (sec < 10) half<3, 768, 512>(acc, bj, row0, col0);
            else if (sec < 14) half<4, 1280, 512>(acc, bj, row0, col0);
            else if (sec < 22) half<2, 1792, 1024>(acc, bj, row0, col0);
            else if (sec < 30) half<5, 2816, 1024>(acc, bj, row0, col0);
            else if (sec < 38) half<6, 3840, 1024>(acc, bj, row0, col0);
            else half<6, 4864, 1024>(acc, bj, row0, col0);
        }
    }
};
struct EpiGateA {
    static constexpr bool PERM = true, AFTER_DRAIN = false;
    bf16_t* P;
    __device__ __forceinline__ void operator()(const f32x4 (&acc)[2][2][4][2], const Unit& u, int wr, int wc, int fr, int fq) const {
        const int row0 = u.pm * BM + wr * 64 + fr;
#pragma unroll
        for (int ai = 0; ai < 2; ++ai)
#pragma unroll
            for (int m = 0; m < 4; ++m)
#pragma unroll
                for (int bj = 0; bj < 2; ++bj) {
                    const int row = row0 + ai * HALF + m * 16, col0 = u.pn * BM + bj * HALF + wc * 32 + 8 * fq;
                    u32x4* p = (u32x4*)(P + MROWS * 3840 + (size_t)row * 1024 + col0); const u32x4 g = *p;
                    const f32x4 g0 = (f32x4){bflo(g.x), bfhi(g.x), bflo(g.y), bfhi(g.y)}, g1 = (f32x4){bflo(g.z), bfhi(g.z), bflo(g.w), bfhi(g.w)};
                    *p = pack8(acc[ai][bj][m][0] * g0, acc[ai][bj][m][1] * g1);
                }
    }
};
struct EpiMerge {
    static constexpr bool PERM = true, AFTER_DRAIN = false;
    bf16_t* P;
    __device__ __forceinline__ void operator()(const f32x4 (&acc)[2][2][4][2], const Unit& u, int wr, int wc, int fr, int fq) const {
        const int row0 = u.pm * BM + wr * 64 + fr;
#pragma unroll
        for (int ai = 0; ai < 2; ++ai)
#pragma unroll
            for (int m = 0; m < 4; ++m)
#pragma unroll
                for (int bj = 0; bj < 2; ++bj) {
                    const int row = row0 + ai * HALF + m * 16, col0 = u.pn * BM + bj * HALF + wc * 32 + 8 * fq;
                    const u32x4 t = *(const u32x4*)(P + MROWS * 3840 + (size_t)row * 1024 + col0);
                    u32x4* p = (u32x4*)(P + MROWS * 4864 + (size_t)row * 1024 + col0); const u32x4 g = *p;
                    const f32x4 g0 = (f32x4){bflo(g.x), bfhi(g.x), bflo(g.y), bfhi(g.y)}, g1 = (f32x4){bflo(g.z), bfhi(g.z), bflo(g.w), bfhi(g.w)};
                    const f32x4 t0 = (f32x4){bflo(t.x), bfhi(t.x), bflo(t.y), bfhi(t.y)}, t1 = (f32x4){bflo(t.z), bfhi(t.z), bflo(t.w), bfhi(t.w)};
                    *p = pack8(t0 + acc[ai][bj][m][0] * g0, t1 + acc[ai][bj][m][1] * g1);
                }
    }
};
struct EpiOut {
    static constexpr bool PERM = true, AFTER_DRAIN = false;
    const float* x; float* h1; bf16_t* xn2; const float* gain; float* ss;
    __device__ __forceinline__ void operator()(const f32x4 (&acc)[2][2][4][2], const Unit& u, int wr, int wc, int fr, int fq) const {
        const int row0 = u.pm * BM + wr * 64 + fr;
#pragma unroll
        for (int ai = 0; ai < 2; ++ai)
#pragma unroll
            for (int m = 0; m < 4; ++m) {
                const int row = row0 + ai * HALF + m * 16; float sq = 0.f;
#pragma unroll
                for (int bj = 0; bj < 2; ++bj) {
                    const int col0 = u.pn * BM + bj * HALF + wc * 32 + 8 * fq; const size_t off = (size_t)row * 1024 + col0;
                    const f32x4 ha = *(const f32x4*)(x + off) + acc[ai][bj][m][0], hb = *(const f32x4*)(x + off + 4) + acc[ai][bj][m][1];
                    *(f32x4*)(h1 + off) = ha; *(f32x4*)(h1 + off + 4) = hb;
                    sq += (ha[0] * ha[0] + ha[1] * ha[1]) + (ha[2] * ha[2] + ha[3] * ha[3]) + (hb[0] * hb[0] + hb[1] * hb[1]) + (hb[2] * hb[2] + hb[3] * hb[3]);
                    const f32x4 g0 = *(const f32x4*)(gain + col0), g1 = *(const f32x4*)(gain + col0 + 4);
                    *(u32x4*)(xn2 + off) = pack8(ha * g0, hb * g1);
                }
                asm volatile("s_nop 4" : "+v"(sq)); sq += __shfl_xor(sq, 16); asm volatile("s_nop 4" : "+v"(sq)); sq += __shfl_xor(sq, 32);
                if (fq == 0) atomicAdd(ss + row, sq);
            }
    }
};
struct EpiFF1 {
    static constexpr bool PERM = true, AFTER_DRAIN = false;
    bf16_t* hid; const float* ss;
    __device__ __forceinline__ void operator()(const f32x4 (&acc)[2][2][4][2], const Unit& u, int wr, int wc, int fr, int fq) const {
        const int row0 = u.pm * BM + wr * 64 + fr;
#pragma unroll
        for (int ai = 0; ai < 2; ++ai)
#pragma unroll
            for (int m = 0; m < 4; ++m) {
                const int row = row0 + ai * HALF + m * 16; const float r = rsqrtf(ss[row] * (1.0f / 1024.0f) + 1e-6f);
#pragma unroll
                for (int bj = 0; bj < 2; ++bj) {
                    const int col0 = u.pn * BM + bj * HALF + wc * 32 + 8 * fq;
                    f32x4 v0 = acc[ai][bj][m][0] * r, v1 = acc[ai][bj][m][1] * r;
#pragma unroll
                    for (int e = 0; e < 4; ++e) { const float a = fmaxf(v0[e], 0.f), b = fmaxf(v1[e], 0.f); v0[e] = a * a; v1[e] = b * b; }
                    *(u32x4*)(hid + (size_t)row * 4096 + col0) = pack8(v0, v1);
                }
            }
    }
};
struct EpiFF2 {
    static constexpr bool PERM = true, AFTER_DRAIN = false;
    float* h; float* ss;
    __device__ __forceinline__ void operator()(const f32x4 (&acc)[2][2][4][2], const Unit& u, int wr, int wc, int fr, int fq) const {
        const int row0 = u.pm * BM + wr * 64 + fr;
#pragma unroll
        for (int ai = 0; ai < 2; ++ai)
#pragma unroll
            for (int m = 0; m < 4; ++m) {
                const int row = row0 + ai * HALF + m * 16; float sq = 0.f;
#pragma unroll
                for (int bj = 0; bj < 2; ++bj) {
                    const int col0 = u.pn * BM + bj * HALF + wc * 32 + 8 * fq; const size_t off = (size_t)row * 1024 + col0;
                    const f32x4 ha = *(const f32x4*)(h + off) + acc[ai][bj][m][0], hb = *(const f32x4*)(h + off + 4) + acc[ai][bj][m][1];
                    *(f32x4*)(h + off) = ha; *(f32x4*)(h + off + 4) = hb;
                    sq += (ha[0] * ha[0] + ha[1] * ha[1]) + (ha[2] * ha[2] + ha[3] * ha[3]) + (hb[0] * hb[0] + hb[1] * hb[1]) + (hb[2] * hb[2] + hb[3] * hb[3]);
                }
                asm volatile("s_nop 4" : "+v"(sq)); sq += __shfl_xor(sq, 16); asm volatile("s_nop 4" : "+v"(sq)); sq += __shfl_xor(sq, 32);
                if (fq == 0) atomicAdd(ss + row, sq);
            }
    }
};

template <class Epi, class Sched, bool ALIGN_EPI, bool SP2, int KC, int LDAC>
__device__ __forceinline__ void gemm_phase(PG8_LAS unsigned char* lds, const Gemm g, const Sched& S, const Epi& E) {
    int tid_ = threadIdx.x; asm volatile("" : "+v"(tid_)); const int tid = tid_, wid = __builtin_amdgcn_readfirstlane(tid >> 6), lane = tid & 63, wr = wid >> 2, wc = wid & 3, fr = lane & 15, fq = lane >> 4;
    constexpr int K = KC, nt = KC / BK, lda = LDAC;
    unsigned voffA[2], voffB[2];
#pragma unroll
    for (int i = 0; i < 2; ++i) { int R, C; stage_rc(tid * 16 + i * 8192, R, C); const int Rb = Epi::PERM ? ((R & ~31) + perm32(R & 31)) : R;
        voffA[i] = (unsigned)(R * lda + C) * 2u; voffB[i] = (unsigned)(Rb * K + C) * 2u; }
    const size_t kstep = (size_t)(BK * 2);
    const size_t hstepA = (size_t)HALF * lda * 2, hstepB = (size_t)HALF * K * 2;
    const size_t tstepA = 2 * hstepA, tstepB = 2 * hstepB;
    const unsigned ldsw = (unsigned)wid * 1024u;
    const int aoff = lds_byte(wr * 64 + fr, fq * 8), boff = lds_byte(wc * 32 + fr, fq * 8);
#define PG8_SA(b, h) (((b) * 2 + (h)) * HTB)
#define PG8_SB(b, h) ((4 + (b) * 2 + (h)) * HTB)
#define PG8_STAGE(bufoff, gbase, voff) do { _Pragma("unroll") for (int _i = 0; _i < 2; ++_i) \
        __builtin_amdgcn_global_load_lds((const unsigned*)((const char*)(gbase) + (voff)[_i]), (PG8_LAS unsigned*)(lds + (bufoff) + ldsw + _i * 8192), 16, 0, 0); } while (0)
#define PG8_LDA(dst, b, h) do { _Pragma("unroll") for (int m = 0; m < 4; ++m) _Pragma("unroll") for (int k = 0; k < 2; ++k) dst[m][k] = *(const PG8_LAS bf16x8*)(lds + PG8_SA(b, h) + aoff + m * 2048 + k * 1024); } while (0)
#define PG8_LDB(dst, b, h) do { _Pragma("unroll") for (int n = 0; n < 2; ++n) _Pragma("unroll") for (int k = 0; k < 2; ++k) dst[n][k] = *(const PG8_LAS bf16x8*)(lds + PG8_SB(b, h) + boff + n * 2048 + k * 1024); } while (0)
#define PG8_MMA(ai, bj, At, Bt) do { __builtin_amdgcn_s_setprio(1); _Pragma("unroll") for (int m = 0; m < 4; ++m) _Pragma("unroll") for (int n = 0; n < 2; ++n) _Pragma("unroll") for (int k = 0; k < 2; ++k) \
        acc[ai][bj][m][n] = __builtin_amdgcn_mfma_f32_16x16x32_bf16(Bt[n][k], At[m][k], acc[ai][bj][m][n], 0, 0, 0); __builtin_amdgcn_s_setprio(0); } while (0)
#define PG8_WAIT_V(n) asm volatile("s_waitcnt vmcnt(" #n ")" ::: "memory")
#define PG8_WAIT_L(n) asm volatile("s_waitcnt lgkmcnt(" #n ")" ::: "memory")
#define PG8_BAR __builtin_amdgcn_s_barrier()
#define PG8_SCHED __builtin_amdgcn_sched_barrier(0)
    Unit cur, nxt; int ui = 0;
    if (!S.next(0, cur)) return;
    f32x4 acc[2][2][4][2];
#pragma unroll
    for (int a = 0; a < 2; ++a)
#pragma unroll
        for (int b = 0; b < 2; ++b)
#pragma unroll
            for (int m = 0; m < 4; ++m)
#pragma unroll
                for (int n = 0; n < 2; ++n) acc[a][b][m][n] = (f32x4){0.f, 0.f, 0.f, 0.f};
    bf16x8 At[4][2], B0[2][2], B1[2][2];
    const char* cA = (const char*)g.A + (size_t)cur.pm * tstepA; const char* cB = (const char*)g.Bt + (size_t)cur.pn * tstepB;
    S.a_ready(cur);
    if constexpr (SP2) {
        PG8_STAGE(PG8_SB(0, 0), cB, voffB); PG8_STAGE(PG8_SB(0, 1), cB + hstepB, voffB); PG8_STAGE(PG8_SA(0, 0), cA, voffA); PG8_STAGE(PG8_SA(0, 1), cA + hstepA, voffA);
        if (wr == 1) PG8_BAR;
        PG8_WAIT_V(2); PG8_BAR;
        PG8_STAGE(PG8_SB(1, 0), cB + kstep, voffB); PG8_STAGE(PG8_SA(1, 0), cA + kstep, voffA); PG8_STAGE(PG8_SB(1, 1), cB + hstepB + kstep, voffB);
        PG8_WAIT_V(6); PG8_BAR;
    } else {
        PG8_STAGE(PG8_SB(0, 0), cB, voffB); PG8_STAGE(PG8_SA(0, 0), cA, voffA); PG8_STAGE(PG8_SB(0, 1), cB + hstepB, voffB); PG8_STAGE(PG8_SA(0, 1), cA + hstepA, voffA);
        if (wr == 1) PG8_BAR;
        PG8_WAIT_V(4); PG8_BAR;
        PG8_STAGE(PG8_SB(1, 0), cB + kstep, voffB); PG8_STAGE(PG8_SA(1, 0), cA + kstep, voffA); PG8_STAGE(PG8_SB(1, 1), cB + hstepB + kstep, voffB);
        PG8_WAIT_V(6); PG8_BAR;
    }
    for (;;) {
        const bool has_next = S.next(ui + 1, nxt);
        const char* nA = has_next ? (const char*)g.A + (size_t)nxt.pm * tstepA : cA; const char* nB = has_next ? (const char*)g.Bt + (size_t)nxt.pn * tstepB : cB;
        for (int t = 0; t < nt; t += 2) {
            const bool last = (t == nt - 2);
            const char* a1 = cA + (size_t)(t + 1) * kstep;
            const char* a2 = last ? nA : cA + (size_t)(t + 2) * kstep; const char* b2 = last ? nB : cB + (size_t)(t + 2) * kstep;
            const char* a3 = a2 + kstep; const char* b3 = b2 + kstep;
            if (last && has_next) S.a_ready(nxt);
            if constexpr (SP2) {
            PG8_LDB(B0, 0, 0); PG8_LDB(B1, 0, 1); PG8_SCHED; PG8_LDA(At, 0, 0); PG8_STAGE(PG8_SA(1, 1), a1 + hstepA, voffA);
            PG8_WAIT_V(8); PG8_WAIT_L(0); PG8_BAR; PG8_MMA(0, 0, At, B0); PG8_MMA(0, 1, At, B1); PG8_BAR; PG8_SCHED;
            PG8_LDA(At, 0, 1); PG8_STAGE(PG8_SB(0, 0), b2, voffB); PG8_STAGE(PG8_SB(0, 1), b2 + hstepB, voffB); PG8_STAGE(PG8_SA(0, 0), a2, voffA);
            PG8_WAIT_V(8); PG8_WAIT_L(0); PG8_BAR; PG8_MMA(1, 0, At, B0); PG8_MMA(1, 1, At, B1); PG8_BAR; PG8_SCHED;
            PG8_LDB(B0, 1, 0); PG8_LDB(B1, 1, 1); PG8_SCHED; PG8_LDA(At, 1, 0); PG8_STAGE(PG8_SA(0, 1), a2 + hstepA, voffA);
            PG8_WAIT_V(8); PG8_WAIT_L(0); PG8_BAR; PG8_MMA(0, 0, At, B0); PG8_MMA(0, 1, At, B1); PG8_BAR; PG8_SCHED;
            PG8_LDA(At, 1, 1); PG8_STAGE(PG8_SB(1, 0), b3, voffB); PG8_STAGE(PG8_SB(1, 1), b3 + hstepB, voffB); PG8_STAGE(PG8_SA(1, 0), a3, voffA);
            PG8_WAIT_V(8); PG8_WAIT_L(0); PG8_BAR; PG8_MMA(1, 0, At, B0); PG8_MMA(1, 1, At, B1); PG8_BAR; PG8_SCHED;
            } else {
            PG8_LDB(B0, 0, 0); PG8_SCHED; PG8_LDA(At, 0, 0); PG8_STAGE(PG8_SA(1, 1), a1 + hstepA, voffA);
            PG8_WAIT_L(8); PG8_BAR; PG8_WAIT_L(0); PG8_MMA(0, 0, At, B0); PG8_BAR; PG8_SCHED;
            PG8_LDB(B1, 0, 1); PG8_STAGE(PG8_SB(0, 0), b2, voffB);
            PG8_BAR; PG8_WAIT_L(0); PG8_MMA(0, 1, At, B1); PG8_BAR;
            PG8_LDA(At, 0, 1); PG8_STAGE(PG8_SA(0, 0), a2, voffA);
            PG8_BAR; PG8_WAIT_L(0); PG8_MMA(1, 0, At, B0); PG8_BAR; PG8_SCHED;
            PG8_STAGE(PG8_SB(0, 1), b2 + hstepB, voffB);
            PG8_WAIT_V(6); PG8_BAR; PG8_MMA(1, 1, At, B1); PG8_BAR;
            PG8_LDB(B0, 1, 0); PG8_SCHED; PG8_LDA(At, 1, 0); PG8_STAGE(PG8_SA(0, 1), a2 + hstepA, voffA);
            PG8_WAIT_L(8); PG8_BAR; PG8_WAIT_L(0); PG8_MMA(0, 0, At, B0); PG8_BAR; PG8_SCHED;
            PG8_LDB(B1, 1, 1); PG8_STAGE(PG8_SB(1, 0), b3, voffB);
            PG8_BAR; PG8_WAIT_L(0); PG8_MMA(0, 1, At, B1); PG8_BAR;
            PG8_LDA(At, 1, 1); PG8_STAGE(PG8_SA(1, 0), a3, voffA);
            PG8_BAR; PG8_WAIT_L(0); PG8_MMA(1, 0, At, B0); PG8_BAR; PG8_SCHED;
            PG8_STAGE(PG8_SB(1, 1), b3 + hstepB, voffB);
            PG8_WAIT_V(6); PG8_BAR; PG8_MMA(1, 1, At, B1); PG8_BAR;
            }
        }
        if constexpr (ALIGN_EPI) { if (wr == 0) PG8_BAR; }
        if constexpr (!Epi::AFTER_DRAIN) { E(acc, cur, wr, wc, fr, fq); S.done(cur); }
        if (!has_next) break;
#pragma unroll
        for (int a = 0; a < 2; ++a)
#pragma unroll
            for (int b = 0; b < 2; ++b)
#pragma unroll
                for (int m = 0; m < 4; ++m)
#pragma unroll
                    for (int n = 0; n < 2; ++n) acc[a][b][m][n] = (f32x4){0.f, 0.f, 0.f, 0.f};
        cur = nxt; cA = nA; cB = nB; ++ui;
        if constexpr (ALIGN_EPI) { if (wr == 1) PG8_BAR; }
    }
    PG8_WAIT_V(0);
    if constexpr (!ALIGN_EPI) { if (wr == 0) PG8_BAR; }
    PG8_BAR;
    if constexpr (Epi::AFTER_DRAIN) { E.fused(acc, cur, wr, wc, fr, fq, lds, wid, lane); S.done(cur); }
#undef PG8_SA
#undef PG8_SB
#undef PG8_STAGE
#undef PG8_LDA
#undef PG8_LDB
#undef PG8_MMA
#undef PG8_WAIT_V
#undef PG8_WAIT_L
#undef PG8_BAR
#undef PG8_SCHED
}
}

#define LAS __attribute__((address_space(3)))
typedef unsigned short bf16_t;
typedef unsigned u32x4 __attribute__((ext_vector_type(4)));
typedef unsigned u32x2 __attribute__((ext_vector_type(2)));
typedef float f32x4 __attribute__((ext_vector_type(4)));
typedef float f32x16 __attribute__((ext_vector_type(16)));
typedef short bf16x8 __attribute__((ext_vector_type(8)));
typedef short s16x4 __attribute__((ext_vector_type(4)));
using pg8::pk2;

constexpr int NT = 512;
constexpr int LDS_BYTES = 147456;
constexpr int M = 32768, D = 1024, SEQ = 4096, PW = 5888, FF = 4096;
constexpr size_t MiB = 1u << 20;
constexpr size_t SEC_QA = 0, SEC_KA = (size_t)M * 512, SEC_VA = (size_t)M * 640, SEC_QR = (size_t)M * 768, SEC_KR = (size_t)M * 1280, SEC_VR = (size_t)M * 1792, SEC_GR = (size_t)M * 2816, SEC_GB = (size_t)M * 4864;
constexpr size_t WS_WIN = 0, WS_WATT = 12 * MiB, WS_WRET = 13 * MiB, WS_WOUT = 15 * MiB, WS_W1 = 17 * MiB, WS_W2 = 25 * MiB;
constexpr size_t WS_TABA = 33 * MiB, WS_TABR = 34 * MiB, WS_SS1 = 36 * MiB, WS_SS2 = 36 * MiB + 512 * 1024;
constexpr size_t WS_CTL = 37 * MiB, CTL_BYTES = 16384;
constexpr int LDS_ST_OFF = LDS_BYTES - 16;
constexpr size_t WS_SX = 38 * MiB;
constexpr size_t WS_XN = 40 * MiB;
constexpr size_t WS_PROJ = 104 * MiB;
constexpr size_t WS_END = 472 * MiB;

struct Args { const float* in[13]; float* out; unsigned char* ws; };
#define XB_SYNC() xcd_barrier(xbar)

__device__ __forceinline__ float settle(float v) { asm volatile("s_nop 4" : "+v"(v)); return v; }
__device__ __forceinline__ float wave_sum(float v) {
#pragma unroll
    for (int o = 1; o < 64; o <<= 1) { v = settle(v); v += __shfl_xor(v, o); }
    return v;
}
__device__ __forceinline__ float ex2(float v) { return __builtin_amdgcn_exp2f(v); }
template <int CTRL> __device__ __forceinline__ float dpp_f(float v) { return __builtin_bit_cast(float, __builtin_amdgcn_update_dpp(0, __builtin_bit_cast(int, v), CTRL, 0xF, 0xF, false)); }
__device__ __forceinline__ float rsum16(float v) { v = settle(v); v += dpp_f<0xB1>(v); v = settle(v); v += dpp_f<0x4E>(v); v = settle(v); v += dpp_f<0x124>(v); v = settle(v); v += dpp_f<0x128>(v); return settle(v); }
__device__ __forceinline__ int crow(int r, int hi) { return (r & 3) + 8 * (r >> 2) + 4 * hi; }


#define XB_TMO      128
#define XB_XCNT(j)  (256  + 64 * (j))
#define XB_XSUB(j)  (1280 + 64 * (j))
#define XB_XGEN(j)  (2304 + 64 * (j))
#define XB_TOP      3328
#define XB_TOPGEN   3392
#define XCD_BAR_WORDS 3456
#define XB_SPIN_CAP (1u << 18)
__device__ __forceinline__ unsigned xb_ld(unsigned* p)              { return __hip_atomic_load(p, __ATOMIC_RELAXED, __HIP_MEMORY_SCOPE_AGENT); }
__device__ __forceinline__ unsigned xb_add(unsigned* p, unsigned v) { return __hip_atomic_fetch_add(p, v, __ATOMIC_RELAXED, __HIP_MEMORY_SCOPE_AGENT); }
__device__ __forceinline__ unsigned xb_xcc_id() { return (unsigned)__builtin_amdgcn_s_getreg((3 << 11) | 20) & 0xFu; }
#define XB_SPIN(cond, bar) do { unsigned _sp = 0; while (cond) { __builtin_amdgcn_s_sleep(1); \
    if ((++_sp & 255u) == 0u) { if (xb_ld(&(bar)[XB_TMO])) break; if (_sp > XB_SPIN_CAP) { atomicAdd(&(bar)[XB_TMO], 1u); break; } } } } while (0)
struct XcdBarrier { unsigned* bar; unsigned x; volatile LAS unsigned* st; };
__device__ __forceinline__ XcdBarrier xcd_barrier_post(unsigned* bar, volatile LAS unsigned* st) {
    XcdBarrier b; b.bar = bar; b.x = xb_xcc_id(); b.st = st;
    if (threadIdx.x == 0) (void)xb_add(&bar[XB_XCNT(b.x)], 1u);
    return b;
}
__device__ __forceinline__ void xcd_barrier_complete(unsigned* bar, unsigned x, unsigned& nloc, unsigned& nx) {
    const unsigned G = gridDim.x * gridDim.y * gridDim.z;
    unsigned sum, cnt, mine, sp = 0u;
    for (;;) {
        sum = 0u; cnt = 0u; mine = 0u;
#pragma unroll
        for (unsigned j = 0; j < 16; ++j) { const unsigned c = xb_ld(&bar[XB_XCNT(j)]); sum += c; cnt += (c > 0u) ? 1u : 0u; mine = (j == x) ? c : mine; }
        if (sum == G) break;
        __builtin_amdgcn_s_sleep(1);
        if ((++sp & 255u) == 0u) { if (xb_ld(&bar[XB_TMO])) break; if (sp > XB_SPIN_CAP) { atomicAdd(&bar[XB_TMO], 1u); break; } }
    }
    nloc = mine > 0u ? mine : 1u; nx = cnt > 0u ? cnt : 1u;
}
__device__ __forceinline__ void xcd_barrier(const XcdBarrier& b) {
    asm volatile("s_waitcnt vmcnt(0)" ::: "memory");
    __syncthreads();
    if (threadIdx.x == 0) {
        unsigned* bar = b.bar;
        __builtin_amdgcn_s_waitcnt(0);
        unsigned nloc = b.st[0], nx = b.st[1];
        if (nloc == 0u) { xcd_barrier_complete(bar, b.x, nloc, nx); b.st[0] = nloc; b.st[1] = nx; }
        const unsigned old = xb_add(&bar[XB_XSUB(b.x)], 1u);
        const unsigned gen = old / nloc;
        if (old + 1u == (gen + 1u) * nloc) {
            __builtin_amdgcn_fence(__ATOMIC_RELEASE, "agent");
            asm volatile("s_waitcnt vmcnt(0)" ::: "memory");
            const unsigned og = xb_add(&bar[XB_TOP], 1u);
            const unsigned tg = og / nx;
            if (og + 1u == (tg + 1u) * nx) xb_add(&bar[XB_TOPGEN], 1u);
            else XB_SPIN(xb_ld(&bar[XB_TOPGEN]) == tg, bar);
            __builtin_amdgcn_fence(__ATOMIC_ACQUIRE, "");
            asm volatile("s_waitcnt vmcnt(0)" ::: "memory");
            xb_add(&bar[XB_XGEN(b.x)], 1u);
        } else {
            XB_SPIN(xb_ld(&bar[XB_XGEN(b.x)]) == gen, bar);
            __builtin_amdgcn_fence(__ATOMIC_ACQUIRE, "agent");
            asm volatile("s_waitcnt vmcnt(0)" ::: "memory");
        }
    }
    __syncthreads();
}

__device__ __forceinline__ int src_col(int n) {
    if (n < 640) { const int p = n & 63; if (p < 16) { const int g = p >> 3, w = p & 7; return (n & ~63) + ((w < 4) ? (4 * g + w) : (8 + 4 * g + (w - 4))); } return n; }
    if (n >= 768 && n < 1792) { const int p = n & 127, g = p >> 3, w = p & 7; return (n & ~127) + ((w < 4) ? (4 * g + w) : (64 + 4 * g + (w - 4))); }
    return n;
}
__device__ __forceinline__ void p0_transpose_item(const float* W, int K, int N, bf16_t* WT, LAS float* scr, int item, int lane, bool perm) {
    const int nblk = N / 32, kb = item / nblk, nb = item % nblk, k0 = 64 * kb, n0 = 32 * nb;
    const int ncol = perm ? src_col(n0 + (lane & 31)) : (n0 + (lane & 31));
#pragma unroll
    for (int i = 0; i < 32; ++i) { const int kk = 2 * i + (lane >> 5); scr[kk * 33 + (lane & 31)] = W[(size_t)(k0 + kk) * N + ncol]; }
    asm volatile("s_waitcnt lgkmcnt(0)" ::: "memory");
    const int c = lane & 7;
#pragma unroll
    for (int j = 0; j < 4; ++j) { const int n = (lane >> 3) + 8 * j; const LAS float* s = scr + (8 * c) * 33 + n;
        u32x4 o; o.x = pk2(s[0 * 33], s[1 * 33]); o.y = pk2(s[2 * 33], s[3 * 33]); o.z = pk2(s[4 * 33], s[5 * 33]); o.w = pk2(s[6 * 33], s[7 * 33]);
        *(u32x4*)(WT + (size_t)(n0 + n) * K + k0 + 8 * c) = o; }
    asm volatile("s_waitcnt lgkmcnt(0)" ::: "memory");
}
__device__ __forceinline__ void rope_entry(float theta, int dim, int pos, int i, float* out2) {
    const float e = -(float)(2 * i) / (float)dim;
    const float inv_freq = (float)exp((double)e * log((double)theta));
    const float ang = (float)pos * inv_freq;
    const double a = (double)ang;
    const double qd = rint(a * 0.63661977236758134308);
    const double r = a - qd * 1.57079632679489661923, r2 = r * r;
    const double sn = r * (1.0 - r2 / 6.0 * (1.0 - r2 / 20.0 * (1.0 - r2 / 42.0 * (1.0 - r2 / 72.0 * (1.0 - r2 / 110.0 * (1.0 - r2 / 156.0))))));
    const double cs = 1.0 - r2 / 2.0 * (1.0 - r2 / 12.0 * (1.0 - r2 / 30.0 * (1.0 - r2 / 56.0 * (1.0 - r2 / 90.0 * (1.0 - r2 / 132.0 * (1.0 - r2 / 182.0))))));
    const int qq = ((int)qd) & 3;
    double c2 = cs, s2 = sn;
    if (qq == 1) { c2 = -sn; s2 = cs; } else if (qq == 2) { c2 = -cs; s2 = -sn; } else if (qq == 3) { c2 = sn; s2 = -cs; }
    out2[0] = (float)c2; out2[1] = (float)s2;
}

__device__ __forceinline__ void attn_unit(LAS unsigned char* lds, bf16_t* P, const float* sinks, int unit, int tid) {
    asm volatile("" : "+v"(tid));
    const int lane = tid & 63, w = __builtin_amdgcn_readfirstlane(tid >> 6), r32 = lane & 31, h = lane >> 5;
    const int blk = unit & 31, kvh = (unit >> 5) & 1, b = unit >> 6;
    const long rowbase = (long)b * SEQ + blk * 128;
    LAS unsigned char* Ks = lds;
    LAS unsigned short* Vt = (LAS unsigned short*)(lds + 36864);
#pragma unroll
    for (int i = 0; i < 4; ++i) {
        const int idx = tid + i * 512, key = idx & 255, ch = idx >> 8;
        const bool valid = (blk > 0) || (key >= 128);
        u32x4 kv = (u32x4){0u, 0u, 0u, 0u}, vv = kv;
        if (valid) { const size_t r = (size_t)(rowbase - 128 + key); kv = *(const u32x4*)(P + SEC_KA + r * 128 + kvh * 64 + ch * 8); vv = *(const u32x4*)(P + SEC_VA + r * 128 + kvh * 64 + ch * 8); }
        *(LAS u32x4*)(Ks + key * 144 + ch * 16) = kv;
        LAS unsigned short* vd = Vt + (ch * 8) * 260 + key;
        vd[0 * 260] = (unsigned short)(vv.x & 0xffffu); vd[1 * 260] = (unsigned short)(vv.x >> 16);
        vd[2 * 260] = (unsigned short)(vv.y & 0xffffu); vd[3 * 260] = (unsigned short)(vv.y >> 16);
        vd[4 * 260] = (unsigned short)(vv.z & 0xffffu); vd[5 * 260] = (unsigned short)(vv.z >> 16);
        vd[6 * 260] = (unsigned short)(vv.w & 0xffffu); vd[7 * 260] = (unsigned short)(vv.w >> 16);
    }
    __syncthreads();
    const int head = kvh * 4 + (w >> 1);
    const float sink = sinks[head];
#pragma unroll 1
    for (int hf = 0; hf < 2; ++hf) {
        const int r0 = (w & 1) * 64 + hf * 32;
        const bf16_t* qptr = P + SEC_QA + (size_t)(rowbase + r0 + r32) * 512 + head * 64 + 8 * h;
        bf16x8 qf[4];
#pragma unroll
        for (int s = 0; s < 4; ++s) qf[s] = *(const bf16x8*)(qptr + 16 * s);
        f32x16 x[5];
#pragma unroll
        for (int kt = 0; kt < 5; ++kt) {
            f32x16 a0;
#pragma unroll
            for (int i = 0; i < 16; ++i) a0[i] = 0.f;
#pragma unroll
            for (int s = 0; s < 4; ++s) { const bf16x8 a = *(const LAS bf16x8*)(Ks + (r0 + kt * 32 + r32) * 144 + (16 * s + 8 * h) * 2); a0 = __builtin_amdgcn_mfma_f32_32x32x16_bf16(a, qf[s], a0, 0, 0, 0); }
            x[kt] = a0;
        }
        const int qi = r0 + r32;
        float mx = sink;
#pragma unroll
        for (int kt = 0; kt < 5; ++kt)
#pragma unroll
            for (int i = 0; i < 16; ++i) { const int f = r0 + kt * 32 + crow(i, h); const bool ok = (f > qi) && (f <= qi + 128) && ((blk > 0) || (f >= 128)); const float v = ok ? x[kt][i] : -1e30f; x[kt][i] = v; mx = fmaxf(mx, v); }
        mx = settle(mx); mx = fmaxf(mx, __shfl_xor(mx, 32));
        float l = 0.f;
#pragma unroll
        for (int kt = 0; kt < 5; ++kt)
#pragma unroll
            for (int i = 0; i < 16; ++i) { const float e = __expf(x[kt][i] - mx); x[kt][i] = e; l += e; }
        l = settle(l); l += __shfl_xor(l, 32); l += __expf(sink - mx);
        const float inv = 1.0f / l;
        f32x16 o[2];
#pragma unroll
        for (int i = 0; i < 16; ++i) { o[0][i] = 0.f; o[1][i] = 0.f; }
#pragma unroll
        for (int kt = 0; kt < 5; ++kt)
#pragma unroll
            for (int s2 = 0; s2 < 2; ++s2) {
                u32x4 pw; pw.x = pk2(x[kt][8 * s2 + 0] * inv, x[kt][8 * s2 + 1] * inv); pw.y = pk2(x[kt][8 * s2 + 2] * inv, x[kt][8 * s2 + 3] * inv);
                pw.z = pk2(x[kt][8 * s2 + 4] * inv, x[kt][8 * s2 + 5] * inv); pw.w = pk2(x[kt][8 * s2 + 6] * inv, x[kt][8 * s2 + 7] * inv);
                const bf16x8 pa = __builtin_bit_cast(bf16x8, pw);
#pragma unroll
                for (int dt = 0; dt < 2; ++dt) {
                    const LAS unsigned short* vb = Vt + (32 * dt + r32) * 260 + r0 + kt * 32 + 16 * s2 + 4 * h;
                    const s16x4 lo = *(const LAS s16x4*)vb, hi = *(const LAS s16x4*)(vb + 8);
                    const bf16x8 vf = __builtin_shufflevector(lo, hi, 0, 1, 2, 3, 4, 5, 6, 7);
                    o[dt] = __builtin_amdgcn_mfma_f32_32x32x16_bf16(pa, vf, o[dt], 0, 0, 0);
                }
            }
#pragma unroll
        for (int dt = 0; dt < 2; ++dt)
#pragma unroll
            for (int i = 0; i < 16; ++i) { const unsigned wv = pk2(o[dt][i], 0.f); P[SEC_QA + (size_t)(rowbase + r0 + crow(i, h)) * 512 + head * 64 + 32 * dt + r32] = (bf16_t)(wv & 0xffffu); }
    }
    __syncthreads();
}

__device__ __forceinline__ void scan_unit(LAS unsigned char* lds, const bf16_t* P, bf16_t* ST, int unit, int tid) {
    asm volatile("" : "+v"(tid));
    const int lane = tid & 63, w = __builtin_amdgcn_readfirstlane(tid >> 6), l15 = lane & 15, q = lane >> 4;
    const int sl = unit & 7, hh = (unit >> 3) & 3, b = unit >> 5;
    const float lg2 = log1pf(-exp2f(-5.0f - (float)hh)) * 1.4426950408889634f;
    const float cdec = ex2(128.0f * lg2);
    LAS unsigned short* Kt = (LAS unsigned short*)lds;
    LAS unsigned short* Vt = Kt + 128 * 128;
    f32x4 acc[2]; acc[0] = (f32x4){0.f, 0.f, 0.f, 0.f}; acc[1] = acc[0];
    const size_t row0 = (size_t)b * SEQ;
    const int kkey0 = tid >> 4, kch = tid & 15, vkey = tid >> 2, vch = tid & 3;
    const bf16_t* kbase = P + SEC_KR + (row0 + kkey0) * 512 + hh * 128 + kch * 8;
    const bf16_t* vbase = P + SEC_VR + (row0 + vkey) * 1024 + hh * 256 + sl * 32 + vch * 8;
    float dec[4];
#pragma unroll
    for (int i = 0; i < 4; ++i) dec[i] = ex2((float)(127 - (kkey0 + 32 * i)) * lg2);
    u32x4 kA[4], vA, kB[4], vB, kC[4], vC, kD[4], vD;
#pragma unroll
    for (int i = 0; i < 4; ++i) { kA[i] = *(const u32x4*)(kbase + (size_t)(32 * i) * 512); kB[i] = *(const u32x4*)(kbase + (size_t)(128 + 32 * i) * 512);
                                  kC[i] = *(const u32x4*)(kbase + (size_t)(256 + 32 * i) * 512); kD[i] = *(const u32x4*)(kbase + (size_t)(384 + 32 * i) * 512); }
    vA = *(const u32x4*)vbase; vB = *(const u32x4*)(vbase + (size_t)128 * 1024); vC = *(const u32x4*)(vbase + (size_t)256 * 1024); vD = *(const u32x4*)(vbase + (size_t)384 * 1024);
    int kpos[8], vpos[8];
#pragma unroll
    for (int e = 0; e < 8; ++e) { const int dk = 8 * kch + e, dv = 8 * vch + e;
        kpos[e] = dk * 128 + ((((kkey0 >> 3) ^ ((dk ^ kch) & 15)) & 15) << 3) + (kkey0 & 7);
        vpos[e] = dv * 128 + ((((vkey >> 3) ^ ((dv ^ vch) & 15)) & 15) << 3) + (vkey & 7); }
    const int rk = 16 * w + l15, gk = (rk ^ (rk >> 3)) & 15, gv0 = (l15 ^ (l15 >> 3)) & 15, gv1 = ((16 + l15) ^ ((16 + l15) >> 3)) & 15;
#define SCAN_STEP(c, KR, VR) do { \
        _Pragma("unroll") for (int tc = 0; tc < 2; ++tc) { u32x2 wv; wv.x = pk2(acc[tc][0], acc[tc][1]); wv.y = pk2(acc[tc][2], acc[tc][3]); \
            *(u32x2*)(ST + ((size_t)((b * 4 + hh) * 32 + (c)) * 256 + sl * 32 + tc * 16 + l15) * 128 + 16 * w + 4 * q) = wv; } \
        __syncthreads(); \
        _Pragma("unroll") for (int i = 0; i < 4; ++i) { const u32x4 kv = KR[i]; const float dc = dec[i]; unsigned t; \
              \
            t = pk2(pg8::bflo(kv.x) * dc, pg8::bfhi(kv.x) * dc); Kt[kpw(kpos[0], i)] = (unsigned short)(t & 0xffffu); Kt[kpw(kpos[1], i)] = (unsigned short)(t >> 16); \
            t = pk2(pg8::bflo(kv.y) * dc, pg8::bfhi(kv.y) * dc); Kt[kpw(kpos[2], i)] = (unsigned short)(t & 0xffffu); Kt[kpw(kpos[3], i)] = (unsigned short)(t >> 16); \
            t = pk2(pg8::bflo(kv.z) * dc, pg8::bfhi(kv.z) * dc); Kt[kpw(kpos[4], i)] = (unsigned short)(t & 0xffffu); Kt[kpw(kpos[5], i)] = (unsigned short)(t >> 16); \
            t = pk2(pg8::bflo(kv.w) * dc, pg8::bfhi(kv.w) * dc); Kt[kpw(kpos[6], i)] = (unsigned short)(t & 0xffffu); Kt[kpw(kpos[7], i)] = (unsigned short)(t >> 16); } \
        { Vt[vpos[0]] = (unsigned short)(VR.x & 0xffffu); Vt[vpos[1]] = (unsigned short)(VR.x >> 16); \
          Vt[vpos[2]] = (unsigned short)(VR.y & 0xffffu); Vt[vpos[3]] = (unsigned short)(VR.y >> 16); \
          Vt[vpos[4]] = (unsigned short)(VR.z & 0xffffu); Vt[vpos[5]] = (unsigned short)(VR.z >> 16); \
          Vt[vpos[6]] = (unsigned short)(VR.w & 0xffffu); Vt[vpos[7]] = (unsigned short)(VR.w >> 16); } \
        if ((c) + 4 < 32) { const size_t offr = (size_t)((c) + 4) * 128; \
            _Pragma("unroll") for (int i = 0; i < 4; ++i) KR[i] = *(const u32x4*)(kbase + (offr + 32 * i) * 512); \
            VR = *(const u32x4*)(vbase + offr * 1024); } \
        __syncthreads(); \
        acc[0] = acc[0] * cdec; acc[1] = acc[1] * cdec; \
        _Pragma("unroll") for (int s = 0; s < 4; ++s) { \
            const bf16x8 a = *(const LAS bf16x8*)(Kt + rk * 128 + (((4 * s + q) ^ gk) << 3)); \
            const bf16x8 b0 = *(const LAS bf16x8*)(Vt + l15 * 128 + (((4 * s + q) ^ gv0) << 3)); \
            const bf16x8 b1 = *(const LAS bf16x8*)(Vt + (16 + l15) * 128 + (((4 * s + q) ^ gv1) << 3)); \
            acc[0] = __builtin_amdgcn_mfma_f32_16x16x32_bf16(a, b0, acc[0], 0, 0, 0); acc[1] = __builtin_amdgcn_mfma_f32_16x16x32_bf16(a, b1, acc[1], 0, 0, 0); } \
    } while (0)
#define kpw(pos, i) ((pos) ^ ((4 * (i)) << 3))
#pragma unroll 1
    for (int c = 0; c < 32; c += 4) { SCAN_STEP(c, kA, vA); SCAN_STEP(c + 1, kB, vB); SCAN_STEP(c + 2, kC, vC); SCAN_STEP(c + 3, kD, vD); }
#undef SCAN_STEP
#undef kpw
    __syncthreads();
}

__device__ __forceinline__ void pos0_partial(LAS unsigned char* lds, const float* x, const float* gmix, const float* win, float* sx, int item, int tid) {
    const int part = item & 3, hh = (item >> 2) & 3, b = item >> 4;
    LAS float* xg = (LAS float*)(lds + 137216);
    LAS float* hp = xg + 256;
    if (tid < 256) { const int k = part * 256 + tid; xg[tid] = x[(size_t)b * SEQ * D + k] * gmix[k]; }
    __syncthreads();
    const int d2 = tid & 255, kh = tid >> 8;
    const float* wp = win + (size_t)(part * 256 + kh * 128) * PW + (d2 < 128 ? 768 + hh * 128 + d2 : 1280 + hh * 128 + (d2 - 128));
    float acc = 0.f;
#pragma unroll 32
    for (int k = 0; k < 128; ++k) acc += xg[kh * 128 + k] * wp[(size_t)k * PW];
    hp[kh * 256 + d2] = acc;
    __syncthreads();
    if (tid < 256) sx[(size_t)item * 256 + tid] = hp[tid] + hp[256 + tid];
    __syncthreads();
}

__device__ __forceinline__ void retout_unit(LAS unsigned char* lds, bf16_t* P, const bf16_t* ST, const float* gn, int unit, int tid, const float* x, const float* sx) {
    asm volatile("" : "+v"(tid));
    const int lane = tid & 63, w = __builtin_amdgcn_readfirstlane(tid >> 6), l15 = lane & 15, q = lane >> 4;
    const int c = unit & 31, hh = (unit >> 5) & 3, b = unit >> 7;
    const size_t rowc = (size_t)b * SEQ + c * 128;
    const float lg2 = log1pf(-exp2f(-5.0f - (float)hh)) * 1.4426950408889634f;
    float s_exact = 0.f;
    if (c == 0) {
        LAS float* red = (LAS float*)(lds + 137216);
        const float* xrow = x + rowc * D;
        float ssq = 0.f;
#pragma unroll
        for (int k = tid; k < 1024; k += 512) { const float xv = xrow[k]; ssq += xv * xv; }
        ssq = wave_sum(ssq); if (lane == 0) red[w] = ssq;
        if (tid < 128) { const float* sp = sx + (size_t)((b * 4 + hh) * 4) * 256 + tid;
                         const float qs = (sp[0] + sp[256]) + (sp[512] + sp[768]), ks = (sp[128] + sp[384]) + (sp[640] + sp[896]);
                         const float pr = wave_sum(qs * ks); if (lane == 0) red[8 + w] = pr; }
        __syncthreads();
        float tot = 0.f;
#pragma unroll
        for (int i = 0; i < 8; ++i) tot += red[i];
        const float rs = rsqrtf(tot * (1.0f / D) + 1e-6f);
        s_exact = (red[8] + red[9]) * rs * rs * 0.08838834764831845f;
    }
    LAS unsigned short* RA = (LAS unsigned short*)lds;
    LAS unsigned short* Ks = (LAS unsigned short*)(lds + 69632);
    const bf16_t* st = ST + (size_t)((b * 4 + hh) * 32 + c) * 32768;
#pragma unroll
    for (int i = 0; i < 8; ++i) { const int idx = tid + i * 512, dv = idx >> 4, ch = idx & 15; *(LAS u32x4*)(RA + dv * 136 + ch * 8) = *(const u32x4*)(st + dv * 128 + ch * 8); }
#pragma unroll
    for (int i = 0; i < 4; ++i) { const int idx = tid + i * 512, key = idx >> 4, ch = idx & 15; *(LAS u32x4*)(Ks + key * 136 + ch * 8) = *(const u32x4*)(P + SEC_KR + (rowc + key) * 512 + hh * 128 + ch * 8); }
    u32x4 vreg[8];
#pragma unroll
    for (int i = 0; i < 8; ++i) { const int idx = tid + i * 512, key = idx & 127, ch = idx >> 7; vreg[i] = *(const u32x4*)(P + SEC_VR + (rowc + key) * 1024 + hh * 256 + ch * 8); }
    bf16x8 qf[4];
#pragma unroll
    for (int s = 0; s < 4; ++s) qf[s] = *(const bf16x8*)(P + SEC_QR + (rowc + 16 * w + l15) * 512 + hh * 128 + 32 * s + 8 * q);
    __syncthreads();
    f32x4 acc[16];
#pragma unroll
    for (int n = 0; n < 16; ++n) {
        f32x4 a0 = (f32x4){0.f, 0.f, 0.f, 0.f};
#pragma unroll
        for (int s = 0; s < (c == 0 ? 0 : 4); ++s) a0 = __builtin_amdgcn_mfma_f32_16x16x32_bf16(qf[s], *(const LAS bf16x8*)(RA + (16 * n + l15) * 136 + 32 * s + 8 * q), a0, 0, 0, 0);
        acc[n] = a0;
    }
    {
        f32x4 qd;
#pragma unroll
        for (int j = 0; j < 4; ++j) qd[j] = ex2((float)(16 * w + 4 * q + j + 1) * lg2);
#pragma unroll
        for (int n = 0; n < 16; ++n) acc[n] = acc[n] * qd;
    }
    f32x4 xt[8];
#pragma unroll
    for (int t = 0; t < 8; ++t) {
        f32x4 a0 = (f32x4){0.f, 0.f, 0.f, 0.f};
        if (t <= w) {
#pragma unroll
            for (int s = 0; s < 4; ++s) a0 = __builtin_amdgcn_mfma_f32_16x16x32_bf16(*(const LAS bf16x8*)(Ks + (16 * t + l15) * 136 + 32 * s + 8 * q), qf[s], a0, 0, 0, 0);
            if (t == 0 && c == 0 && w == 0 && lane == 0) a0[0] = s_exact;
#pragma unroll
            for (int j = 0; j < 4; ++j) { const int d = (16 * w + l15) - (16 * t + 4 * q + j); a0[j] = (d >= 0) ? a0[j] * ex2((float)d * lg2) : 0.f; }
        }
        xt[t] = a0;
    }
    __syncthreads();
#pragma unroll
    for (int i = 0; i < 8; ++i) { const int idx = tid + i * 512, key = idx & 127, ch = idx >> 7; LAS unsigned short* vd = RA + (ch * 8) * 132 + key; const u32x4 vv = vreg[i];
        vd[0 * 132] = (unsigned short)(vv.x & 0xffffu); vd[1 * 132] = (unsigned short)(vv.x >> 16);
        vd[2 * 132] = (unsigned short)(vv.y & 0xffffu); vd[3 * 132] = (unsigned short)(vv.y >> 16);
        vd[4 * 132] = (unsigned short)(vv.z & 0xffffu); vd[5 * 132] = (unsigned short)(vv.z >> 16);
        vd[6 * 132] = (unsigned short)(vv.w & 0xffffu); vd[7 * 132] = (unsigned short)(vv.w >> 16); }
    __syncthreads();
#pragma unroll
    for (int u = 0; u < 4; ++u) {
        if (2 * u <= w) {
            u32x4 pw; pw.x = pk2(xt[2 * u][0], xt[2 * u][1]); pw.y = pk2(xt[2 * u][2], xt[2 * u][3]); pw.z = pk2(xt[2 * u + 1][0], xt[2 * u + 1][1]); pw.w = pk2(xt[2 * u + 1][2], xt[2 * u + 1][3]);
            const bf16x8 pa = __builtin_bit_cast(bf16x8, pw);
#pragma unroll
            for (int n = 0; n < 16; ++n) {
                const LAS unsigned short* vb = RA + (16 * n + l15) * 132 + 32 * u + 4 * q;
                const s16x4 lo = *(const LAS s16x4*)vb, hi = *(const LAS s16x4*)(vb + 16);
                const bf16x8 vf = __builtin_shufflevector(lo, hi, 0, 1, 2, 3, 4, 5, 6, 7);
                acc[n] = __builtin_amdgcn_mfma_f32_16x16x32_bf16(pa, vf, acc[n], 0, 0, 0);
            }
        }
    }
    LAS unsigned short* Yw = (LAS unsigned short*)(lds + 69632) + w * (16 * 264);
    float gnv[16];
#pragma unroll
    for (int n = 0; n < 16; ++n) gnv[n] = gn[hh * 256 + 16 * n + l15];
#pragma unroll
    for (int j = 0; j < 4; ++j) {
        float s = 0.f;
#pragma unroll
        for (int n = 0; n < 16; ++n) s += acc[n][j];
        s = rsum16(s);
        const float mu = s * (1.0f / 256.0f);
        float v = 0.f;
#pragma unroll
        for (int n = 0; n < 16; ++n) { const float d = acc[n][j] - mu; v += d * d; }
        v = rsum16(v);
        const float rstd = rsqrtf(v * (1.0f / 256.0f) + 1e-6f);
#pragma unroll
        for (int n = 0; n < 16; ++n) { const float yn = (acc[n][j] - mu) * rstd * gnv[n]; Yw[(4 * q + j) * 264 + 16 * n + l15] = (unsigned short)(pk2(yn, 0.f) & 0xffffu); }
    }
    {
        u32x4 gq[8]; bf16_t* gp[8];
#pragma unroll
        for (int k = 0; k < 8; ++k) { const int id = lane + 64 * k, row = id >> 5, ch = id & 31; gp[k] = P + SEC_GR + (rowc + 16 * w + row) * 1024 + hh * 256 + ch * 8; gq[k] = *(const u32x4*)gp[k]; }
#pragma unroll
        for (int k = 0; k < 8; ++k) { const int id = lane + 64 * k, row = id >> 5, ch = id & 31;
            const u32x4 yv = *(const LAS u32x4*)(Yw + row * 264 + ch * 8); const u32x4 g = gq[k]; u32x4 o;
            o.x = pk2(pg8::bflo(yv.x) * pg8::bflo(g.x), pg8::bfhi(yv.x) * pg8::bfhi(g.x)); o.y = pk2(pg8::bflo(yv.y) * pg8::bflo(g.y), pg8::bfhi(yv.y) * pg8::bfhi(g.y));
            o.z = pk2(pg8::bflo(yv.z) * pg8::bflo(g.z), pg8::bfhi(yv.z) * pg8::bfhi(g.z)); o.w = pk2(pg8::bflo(yv.w) * pg8::bflo(g.w), pg8::bfhi(yv.w) * pg8::bfhi(g.w));
            *(u32x4*)gp[k] = o; }
    }
    __syncthreads();
}

struct RevOrder : pg8::StaticOrder {
    __device__ __forceinline__ bool next(int i, pg8::Unit& u) const {
        const long L = (long)i * G + c; if (L >= nwg) return false;
        int wgid = nwg - 1 - (int)L; { const int q = nwg / pg8::NXCD, r = nwg % pg8::NXCD, xcd = wgid % pg8::NXCD, off = wgid / pg8::NXCD; wgid = (xcd < r ? xcd * (q + 1) : r * (q + 1) + (xcd - r) * q) + off; }
        const int nig = pg8::WGM * nN, gid = wgid / nig, fm = gid * pg8::WGM, gsz = (nM - fm) < pg8::WGM ? (nM - fm) : pg8::WGM;
        u.pm = fm + ((wgid % nig) % gsz); u.pn = (wgid % nig) / gsz; return true;
    }
};
__global__ void __launch_bounds__(NT, 2) mega(Args a) {
    extern __shared__ __attribute__((aligned(16))) unsigned char lds_raw[];
    LAS unsigned char* lds = (LAS unsigned char*)lds_raw;
    cg::grid_group grid = cg::this_grid();
    const int tid = threadIdx.x, lane = tid & 63, wave = __builtin_amdgcn_readfirstlane(tid >> 6);
    const int G = gridDim.x, bid = blockIdx.x;
    const int gw = bid * 8 + wave, NGW = G * 8;
    unsigned char* ws = a.ws;
    const float* x = a.in[0];
    bf16_t* WinT = (bf16_t*)(ws + WS_WIN); bf16_t* WattT = (bf16_t*)(ws + WS_WATT); bf16_t* WretT = (bf16_t*)(ws + WS_WRET); bf16_t* WoutT = (bf16_t*)(ws + WS_WOUT);
    bf16_t* W1T = (bf16_t*)(ws + WS_W1); bf16_t* W2T = (bf16_t*)(ws + WS_W2);
    float* tabA = (float*)(ws + WS_TABA); float* tabR = (float*)(ws + WS_TABR); float* ss1 = (float*)(ws + WS_SS1); float* ss2 = (float*)(ws + WS_SS2);
    bf16_t* XN = (bf16_t*)(ws + WS_XN); bf16_t* STATE = (bf16_t*)a.out; bf16_t* XN2 = XN;
    bf16_t* PROJ = (bf16_t*)(ws + WS_PROJ); bf16_t* HID = PROJ;
    volatile LAS unsigned* xb_st = (volatile LAS unsigned*)(lds + LDS_ST_OFF);
    if (tid < 2) xb_st[tid] = 0u;
    __syncthreads();
    if (bid == 0) { unsigned* ctl = (unsigned*)(ws + WS_CTL);
#pragma unroll
        for (int i = tid; i < (int)(CTL_BYTES / 4); i += NT) __hip_atomic_store(ctl + i, 0u, __ATOMIC_RELAXED, __HIP_MEMORY_SCOPE_AGENT); }
    asm volatile("s_waitcnt vmcnt(0)" ::: "memory");
    __syncthreads();
    grid.sync();
    const XcdBarrier xbar = xcd_barrier_post((unsigned*)(ws + WS_CTL), xb_st);
    {
        LAS float* scr = (LAS float*)(lds + wave * 16384);
        constexpr int I_IN = 16 * 184;
        for (int it = gw; it < I_IN; it += NGW) p0_transpose_item(a.in[2], 1024, 5888, WinT, scr, it, lane, true);
        const f32x4* gp = (const f32x4*)a.in[1] + lane;
        f32x4 gv[4];
#pragma unroll
        for (int j = 0; j < 4; ++j) gv[j] = gp[64 * j];
        for (int m = gw; m < M; m += 2 * NGW) {
            const int m2 = m + NGW;
            const f32x4* xr = (const f32x4*)(x + (size_t)m * D) + lane;
            const f32x4* xr2 = (const f32x4*)(x + (size_t)(m2 < M ? m2 : m) * D) + lane;
            f32x4 v[4], u[4]; float s = 0.f, s2 = 0.f;
#pragma unroll
            for (int j = 0; j < 4; ++j) { v[j] = xr[64 * j]; u[j] = xr2[64 * j]; }
#pragma unroll
            for (int j = 0; j < 4; ++j) { s += (v[j][0] * v[j][0] + v[j][1] * v[j][1]) + (v[j][2] * v[j][2] + v[j][3] * v[j][3]); s2 += (u[j][0] * u[j][0] + u[j][1] * u[j][1]) + (u[j][2] * u[j][2] + u[j][3] * u[j][3]); }
            const float rs = rsqrtf(wave_sum(s) * (1.0f / D) + 1e-6f), rs2 = rsqrtf(wave_sum(s2) * (1.0f / D) + 1e-6f);
            u32x2* o8 = (u32x2*)(XN + (size_t)m * D) + lane;
#pragma unroll
            for (int j = 0; j < 4; ++j) { u32x2 o; o.x = pk2(v[j][0] * rs * gv[j][0], v[j][1] * rs * gv[j][1]); o.y = pk2(v[j][2] * rs * gv[j][2], v[j][3] * rs * gv[j][3]); o8[64 * j] = o; }
            if (m2 < M) { u32x2* o9 = (u32x2*)(XN + (size_t)m2 * D) + lane;
#pragma unroll
                for (int j = 0; j < 4; ++j) { u32x2 o; o.x = pk2(u[j][0] * rs2 * gv[j][0], u[j][1] * rs2 * gv[j][1]); o.y = pk2(u[j][2] * rs2 * gv[j][2], u[j][3] * rs2 * gv[j][3]); o9[64 * j] = o; } }
        }
        const int gt = bid * NT + tid, NGT = G * NT;
        for (int e = gt; e < SEQ * 8; e += NGT) rope_entry(500000.0f, 16, e >> 3, e & 7, tabA + 2 * e);
        for (int e = gt; e < SEQ * 64; e += NGT) rope_entry(10000.0f, 128, e >> 6, e & 63, tabR + 2 * e);
        for (int e = gt; e < M; e += NGT) { ss1[e] = 0.f; ss2[e] = 0.f; }
    }
    XB_SYNC();
    {
        pg8::Gemm g{XN, WinT, M, PW, 1024, 1024}; pg8::StaticOrder S; S.init(M, PW, G, bid);
        pg8::EpiProj E{PROJ, a.in[3], tabA, tabR};
        pg8::gemm_phase<pg8::EpiProj, pg8::StaticOrder, true, true, 1024, 1024>(lds, g, S, E);
        {
            int nidle = 0, rank = -1;
            const int nwg = (M / 256) * (PW / 256), nr = (nwg + G - 1) / G, first_idle = nwg - (nr - 1) * G;
            if (first_idle < G) { nidle = G - first_idle; rank = bid - first_idle; } else { nidle = G; rank = bid; }
            if (rank >= 0) {
                LAS float* scr = (LAS float*)(lds + wave * 16384);
                constexpr int I_ATT = 8 * 32, I_RET = 16 * 32, I_OUT = 16 * 32, I_1 = 16 * 128, I_2 = 64 * 32, NLATE = I_ATT + I_RET + I_OUT + I_1 + I_2;
                for (int it = rank * 8 + wave; it < NLATE; it += nidle * 8) {
                    int r = it;
                    if (r < I_ATT) { p0_transpose_item(a.in[6], 512, 1024, WattT, scr, r, lane, false); continue; } r -= I_ATT;
                    if (r < I_RET) { p0_transpose_item(a.in[7], 1024, 1024, WretT, scr, r, lane, false); continue; } r -= I_RET;
                    if (r < I_OUT) { p0_transpose_item(a.in[8], 1024, 1024, WoutT, scr, r, lane, false); continue; } r -= I_OUT;
                    if (r < I_1) { p0_transpose_item(a.in[10], 1024, 4096, W1T, scr, r, lane, false); continue; } r -= I_1;
                    p0_transpose_item(a.in[11], 4096, 1024, W2T, scr, r, lane, false);
                }
            }
        }
    }
    XB_SYNC();
    {
        for (int u = bid; u < 768; u += G) {
            if (u < 256) { const int su = (G == 256) ? ((((u & 7) * 4 + ((u >> 3) >> 3)) << 3) | ((u >> 3) & 7)) : u; scan_unit(lds, PROJ, STATE, su, tid); }
            else { attn_unit(lds, PROJ, a.in[4], u - 256, tid); if (u - 256 < 128) pos0_partial(lds, x, a.in[1], a.in[2], (float*)(ws + WS_SX), u - 256, tid); }
        }
    }
    XB_SYNC();
    for (int u = bid; u < 1024; u += G) retout_unit(lds, PROJ, STATE, a.in[5], u, tid, x, (const float*)(ws + WS_SX));
    XB_SYNC();
    {
        pg8::StaticOrder S; S.init(M, 1024, G, bid);
        { pg8::Gemm g{PROJ + SEC_QA, WattT, M, 1024, 512, 512}; pg8::EpiGateA E{PROJ}; pg8::gemm_phase<pg8::EpiGateA, pg8::StaticOrder, true, true, 512, 512>(lds, g, S, E); }
        { pg8::Gemm g{PROJ + SEC_GR, WretT, M, 1024, 1024, 1024}; pg8::EpiMerge E{PROJ}; pg8::gemm_phase<pg8::EpiMerge, pg8::StaticOrder, true, true, 1024, 1024>(lds, g, S, E); }
    }
    XB_SYNC();
    {
        pg8::StaticOrder S; S.init(M, 1024, G, bid);
        pg8::Gemm g{PROJ + SEC_GB, WoutT, M, 1024, 1024, 1024}; pg8::EpiOut E{x, a.out, XN2, a.in[9], ss1};
        pg8::gemm_phase<pg8::EpiOut, pg8::StaticOrder, true, true, 1024, 1024>(lds, g, S, E);
    }
    XB_SYNC();
    {
        pg8::StaticOrder S; S.init(M, FF, G, bid);
        pg8::Gemm g{XN2, W1T, M, FF, 1024, 1024}; pg8::EpiFF1 E{HID, ss1};
        pg8::gemm_phase<pg8::EpiFF1, pg8::StaticOrder, true, true, 1024, 1024>(lds, g, S, E);
    }
    XB_SYNC();
    {
        RevOrder S; S.init(M, 1024, G, bid);
        pg8::Gemm g{HID, W2T, M, 1024, FF, FF}; pg8::EpiFF2 E{a.out, ss2};
        pg8::gemm_phase<pg8::EpiFF2, RevOrder, true, true, FF, FF>(lds, g, S, E);
    }
    XB_SYNC();
    {
        int tid8 = threadIdx.x; asm volatile("" : "+v"(tid8)); int bid8 = blockIdx.x, G8 = gridDim.x; asm volatile("" : "+s"(bid8), "+s"(G8));
        const int lane = tid8 & 63, gw = bid8 * 8 + __builtin_amdgcn_readfirstlane(tid8 >> 6), NGW = G8 * 8;
        const f32x4* gp = (const f32x4*)a.in[12] + lane;
        f32x4 gv[4];
#pragma unroll
        for (int j = 0; j < 4; ++j) gv[j] = gp[64 * j];
        for (int m = gw; m < M; m += NGW) {
            const float rs = rsqrtf(ss2[m] * (1.0f / D) + 1e-6f);
            f32x4* xr = (f32x4*)(a.out + (size_t)m * D) + lane;
#pragma unroll
            for (int j = 0; j < 4; ++j) { f32x4 v = xr[64 * j]; v = v * rs * gv[j]; xr[64 * j] = v; }
        }
    }
}

extern "C" void kernel_launch(void* const* d_in, const int* in_sizes, int n_in, void* d_out, int out_size, void* d_ws, size_t ws_size, hipStream_t stream) {
    static int grid_blocks = 0;
    if (!grid_blocks) {
        if (n_in != 13 || in_sizes[0] != M * D || out_size != M * D || ws_size < WS_END) { fprintf(stderr, "kernel_launch: unexpected shapes / workspace (n_in %d, in0 %d, out %d, ws %zu)\n", n_in, n_in > 0 ? in_sizes[0] : -1, out_size, ws_size); grid_blocks = -1; return; }
        int dev = 0, cus = 0, per_cu = 0;
        hipGetDevice(&dev);
        hipDeviceGetAttribute(&cus, hipDeviceAttributeMultiprocessorCount, dev);
        hipFuncSetAttribute((const void*)mega, hipFuncAttributeMaxDynamicSharedMemorySize, LDS_BYTES);
        hipOccupancyMaxActiveBlocksPerMultiprocessor(&per_cu, (const void*)mega, NT, LDS_BYTES);
        if (per_cu < 1) { fprintf(stderr, "kernel_launch: occupancy query says %d blocks per CU\n", per_cu); per_cu = 1; }
        grid_blocks = cus;
    }
    if (grid_blocks < 0) return;
    Args a{};
    for (int i = 0; i < 13; ++i) a.in[i] = (const float*)d_in[i];
    a.out = (float*)d_out; a.ws = (unsigned char*)d_ws;
    void* args[] = {&a};
    hipError_t e = hipLaunchCooperativeKernel((void*)mega, dim3(grid_blocks), dim3(NT), args, LDS_BYTES, stream);
    if (e != hipSuccess) fprintf(stderr, "cooperative launch failed: %s (grid %d)\n", hipGetErrorString(e), grid_blocks);
}
```

```cpp
#include <hip/hip_runtime.h>
#include <hip/hip_cooperative_groups.h>
#include <cstdio>
#include <cstdint>
namespace cg = cooperative_groups;
namespace pg8 {
#define PG8_LAS __attribute__((address_space(3)))
typedef unsigned short bf16_t;
typedef short bf16x8 __attribute__((ext_vector_type(8)));
typedef float f32x4 __attribute__((ext_vector_type(4)));
typedef unsigned u32x4 __attribute__((ext_vector_type(4)));
constexpr int BM = 256, BK = 64, HALF = 128, HTB = HALF * BK * 2  , STAGE_BYTES = 8 * HTB, NXCD = 8, WGM = 8;

__host__ __device__ __forceinline__ int lds_byte(int r, int c) { const int st = (r >> 4) * 2 + (c >> 5), rr = r & 15, cc = c & 31, ob = rr * 64 + cc * 2; return st * 1024 + (ob ^ (((ob >> 9) & 1) << 5)); }
__host__ __device__ __forceinline__ void stage_rc(int b, int& R, int& C) { const int st = b / 1024, sb = b % 1024, swz = sb ^ (((sb >> 9) & 1) << 5); R = (st >> 1) * 16 + swz / 64; C = (st & 1) * 32 + (swz % 64) / 2; }
__host__ __device__ __forceinline__ int perm32(int rho) { const int n = rho >> 4, i = rho & 15; return 8 * (i >> 2) + 4 * n + (i & 3); }

struct Unit { int pm, pn; };
struct Gemm { const bf16_t* A; const bf16_t* Bt; int M, N, K, lda; };

struct StaticOrder {
    int nM, nN, nwg, G, c;
    __host__ __device__ void init(int M, int N, int G_, int c_) { nM = M / BM; nN = N / BM; nwg = nM * nN; G = G_; c = c_; }
    __host__ __device__ bool next(int i, Unit& u) const {
        const long L = (long)i * G + c; if (L >= nwg) return false;
        int wgid = (int)L; { const int q = nwg / NXCD, r = nwg % NXCD, xcd = wgid % NXCD, off = wgid / NXCD; wgid = (xcd < r ? xcd * (q + 1) : r * (q + 1) + (xcd - r) * q) + off; }
        const int nig = WGM * nN, gid = wgid / nig, fm = gid * WGM, gsz = (nM - fm) < WGM ? (nM - fm) : WGM;
        u.pm = fm + ((wgid % nig) % gsz); u.pn = (wgid % nig) / gsz; return true;
    }
    __device__ __forceinline__ void a_ready(const Unit&) const {}
    __device__ __forceinline__ void done(const Unit&) const {}
};

__device__ __forceinline__ unsigned pk2(float lo, float hi) { typedef float f2_t __attribute__((ext_vector_type(2))); typedef __bf16 b2_t __attribute__((ext_vector_type(2))); f2_t v = {lo, hi}; b2_t b = __builtin_convertvector(v, b2_t); return __builtin_bit_cast(unsigned, b); }
__device__ __forceinline__ float bflo(unsigned w) { return __uint_as_float(w << 16); }
__device__ __forceinline__ float bfhi(unsigned w) { return __uint_as_float(w & 0xffff0000u); }
__device__ __forceinline__ u32x4 pack8(const f32x4 v0, const f32x4 v1) { u32x4 w; w.x = pk2(v0[0], v0[1]); w.y = pk2(v0[2], v0[3]); w.z = pk2(v1[0], v1[1]); w.w = pk2(v1[2], v1[3]); return w; }
__device__ __forceinline__ float sigmoidf_(float v) { return __builtin_amdgcn_rcpf(1.0f + __expf(-v)); }

constexpr int PW = 5888;
constexpr size_t MROWS = 32768;
struct EpiProj {
    static constexpr bool PERM = true, AFTER_DRAIN = false;
    bf16_t* O; const float* bg; const float* tabA; const float* tabR;
    template <int TYPE, int cs, int ws> __device__ __forceinline__ void half(const f32x4 (&acc)[2][2][4][2], int bj, int row0, int col0) const {
        f32x4 b0 = (f32x4){0.f, 0.f, 0.f, 0.f}, b1 = b0;
        if (TYPE == 6) { b0 = *(const f32x4*)(bg + col0 - 3840); b1 = *(const f32x4*)(bg + col0 - 3840 + 4); }
        char* const sbase = (char*)(O + MROWS * cs); const unsigned boff0 = ((unsigned)row0 * (unsigned)ws + (unsigned)(col0 - cs)) * 2u;
        const bool ropeA = (TYPE <= 1) && ((col0 & 63) < 16);
        const int gA = (col0 & 63) >> 3, gR = (col0 & 127) >> 3;
#pragma unroll
        for (int ai = 0; ai < 2; ++ai)
#pragma unroll
            for (int m = 0; m < 4; ++m) {
                const int row = row0 + ai * HALF + m * 16, pos = row & 4095;
                f32x4 v0 = acc[ai][bj][m][0], v1 = acc[ai][bj][m][1];
                if (TYPE == 0 || TYPE == 1) {
                    if (ropeA) {
                        const f32x4* t = (const f32x4*)(tabA + ((size_t)pos * 8 + gA * 4) * 2); const f32x4 t0 = t[0], t1 = t[1];
                        const f32x4 cv = (f32x4){t0[0], t0[2], t1[0], t1[2]}, sn = (f32x4){t0[1], t0[3], t1[1], t1[3]};
                        const f32x4 a = v0 * cv - v1 * sn, bb = v1 * cv + v0 * sn; v0 = a; v1 = bb;
                    }
                    if (TYPE == 0) { v0 = v0 * 0.125f; v1 = v1 * 0.125f; }
                } else if (TYPE == 3 || TYPE == 4) {
                    const f32x4* t = (const f32x4*)(tabR + ((size_t)pos * 64 + gR * 4) * 2); const f32x4 t0 = t[0], t1 = t[1];
                    const f32x4 cv = (f32x4){t0[0], t0[2], t1[0], t1[2]}, sn = (f32x4){t0[1], t0[3], t1[1], t1[3]};
                    const f32x4 a = v0 * cv - v1 * sn, bb = v1 * cv + v0 * sn; v0 = a; v1 = bb;
                    if (TYPE == 4) { v0 = v0 * 0.08838834764831845f; v1 = v1 * 0.08838834764831845f; }
                } else if (TYPE == 5) {
#pragma unroll
                    for (int e = 0; e < 4; ++e) { v0[e] = v0[e] * sigmoidf_(v0[e]); v1[e] = v1[e] * sigmoidf_(v1[e]); }
                } else if (TYPE == 6) {
#pragma unroll
                    for (int e = 0; e < 4; ++e) { v0[e] = sigmoidf_(v0[e] + b0[e]); v1[e] = sigmoidf_(v1[e] + b1[e]); }
                }
                *(u32x4*)(sbase + (boff0 + (unsigned)((ai * HALF + m * 16) * ws * 2))) = pack8(v0, v1);
            }
    }
    __device__ __forceinline__ void operator()(const f32x4 (&acc)[2][2][4][2], const Unit& u, int wr, int wc, int fr, int fq) const {
        const int row0 = u.pm * BM + wr * 64 + fr;
#pragma unroll
        for (int bj = 0; bj < 2; ++bj) {
            const int colbase = u.pn * BM + bj * HALF, sec = colbase >> 7, col0 = colbase + wc * 32 + 8 * fq;
            if (sec < 4) half<0, 0, 512>(acc, bj, row0, col0);
            else if (sec == 4) half<1, 512, 128>(acc, bj, row0, col0);
            else if (sec == 5) half<2, 640, 128>(acc, bj, row0, col0);
            else if (sec < 10) half<3, 768, 512>(acc, bj, row0, col0);
            else if (sec < 14) half<4, 1280, 512>(acc, bj, row0, col0);
            else if (sec < 22) half<2, 1792, 1024>(acc, bj, row0, col0);
            else if (sec < 30) half<5, 2816, 1024>(acc, bj, row0, col0);
            else if (sec < 38) half<6, 3840, 1024>(acc, bj, row0, col0);
            else half<6, 4864, 1024>(acc, bj, row0, col0);
        }
    }
};
struct EpiGateA {
    static constexpr bool PERM = true, AFTER_DRAIN = false;
    bf16_t* P;
    __device__ __forceinline__ void operator()(const f32x4 (&acc)[2][2][4][2], const Unit& u, int wr, int wc, int fr, int fq) const {
        const int row0 = u.pm * BM + wr * 64 + fr;
#pragma unroll
        for (int ai = 0; ai < 2; ++ai)
#pragma unroll
            for (int m = 0; m < 4; ++m)
#pragma unroll
                for (int bj = 0; bj < 2; ++bj) {
                    const int row = row0 + ai * HALF + m * 16, col0 = u.pn * BM + bj * HALF + wc * 32 + 8 * fq;
                    u32x4* p = (u32x4*)(P + MROWS * 3840 + (size_t)row * 1024 + col0); const u32x4 g = *p;
                    const f32x4 g0 = (f32x4){bflo(g.x), bfhi(g.x), bflo(g.y), bfhi(g.y)}, g1 = (f32x4){bflo(g.z), bfhi(g.z), bflo(g.w), bfhi(g.w)};
                    *p = pack8(acc[ai][bj][m][0] * g0, acc[ai][bj][m][1] * g1);
                }
    }
};
struct EpiMerge {
    static constexpr bool PERM = true, AFTER_DRAIN = false;
    bf16_t* P;
    __device__ __forceinline__ void operator()(const f32x4 (&acc)[2][2][4][2], const Unit& u, int wr, int wc, int fr, int fq) const {
        const int row0 = u.pm * BM + wr * 64 + fr;
#pragma unroll
        for (int ai = 0; ai < 2; ++ai)
#pragma unroll
            for (int m = 0; m < 4; ++m)
#pragma unroll
                for (int bj = 0; bj < 2; ++bj) {
                    const int row = row0 + ai * HALF + m * 16, col0 = u.pn * BM + bj * HALF + wc * 32 + 8 * fq;
                    const u32x4 t = *(const u32x4*)(P + MROWS * 3840 + (size_t)row * 1024 + col0);
                    u32x4* p = (u32x4*)(P + MROWS * 4864 + (size_t)row * 1024 + col0); const u32x4 g = *p;
                    const f32x4 g0 = (f32x4){bflo(g.x), bfhi(g.x), bflo(g.y), bfhi(g.y)}, g1 = (f32x4){bflo(g.z), bfhi(g.z), bflo(g.w), bfhi(g.w)};
                    const f32x4 t0 = (f32x4){bflo(t.x), bfhi(t.x), bflo(t.y), bfhi(t.y)}, t1 = (f32x4){bflo(t.z), bfhi(t.z), bflo(t.w), bfhi(t.w)};
                    *p = pack8(t0 + acc[ai][bj][m][0] * g0, t1 + acc[ai][bj][m][1] * g1);
                }
    }
};
struct EpiOut {
    static constexpr bool PERM = true, AFTER_DRAIN = false;
    const float* x; float* h1; bf16_t* xn2; const float* gain; float* ss;
    __device__ __forceinline__ void operator()(const f32x4 (&acc)[2][2][4][2], const Unit& u, int wr, int wc, int fr, int fq) const {
        const int row0 = u.pm * BM + wr * 64 + fr;
#pragma unroll
        for (int ai = 0; ai < 2; ++ai)
#pragma unroll
            for (int m = 0; m < 4; ++m) {
                const int row = row0 + ai * HALF + m * 16; float sq = 0.f;
#pragma unroll
                for (int bj = 0; bj < 2; ++bj) {
                    const int col0 = u.pn * BM + bj * HALF + wc * 32 + 8 * fq; const size_t off = (size_t)row * 1024 + col0;
                    const f32x4 ha = *(const f32x4*)(x + off) + acc[ai][bj][m][0], hb = *(const f32x4*)(x + off + 4) + acc[ai][bj][m][1];
                    *(f32x4*)(h1 + off) = ha; *(f32x4*)(h1 + off + 4) = hb;
                    sq += (ha[0] * ha[0] + ha[1] * ha[1]) + (ha[2] * ha[2] + ha[3] * ha[3]) + (hb[0] * hb[0] + hb[1] * hb[1]) + (hb[2] * hb[2] + hb[3] * hb[3]);
                    const f32x4 g0 = *(const f32x4*)(gain + col0), g1 = *(const f32x4*)(gain + col0 + 4);
                    *(u32x4*)(xn2 + off) = pack8(ha * g0, hb * g1);
                }
                asm volatile("s_nop 4" : "+v"(sq)); sq += __shfl_xor(sq, 16); asm volatile("s_nop 4" : "+v"(sq)); sq += __shfl_xor(sq, 32);
                if (fq == 0) atomicAdd(ss + row, sq);
            }
    }
};
struct EpiFF1 {
    static constexpr bool PERM = true, AFTER_DRAIN = false;
    bf16_t* hid; const float* ss;
    __device__ __forceinline__ void operator()(const f32x4 (&acc)[2][2][4][2], const Unit& u, int wr, int wc, int fr, int fq) const {
        const int row0 = u.pm * BM + wr * 64 + fr;
#pragma unroll
        for (int ai = 0; ai < 2; ++ai)
#pragma unroll
            for (int m = 0; m < 4; ++m) {
                const int row = row0 + ai * HALF + m * 16; const float r = rsqrtf(ss[row] * (1.0f / 1024.0f) + 1e-6f);
#pragma unroll
                for (int bj = 0; bj < 2; ++bj) {
                    const int col0 = u.pn * BM + bj * HALF + wc * 32 + 8 * fq;
                    f32x4 v0 = acc[ai][bj][m][0] * r, v1 = acc[ai][bj][m][1] * r;
#pragma unroll
                    for (int e = 0; e < 4; ++e) { const float a = fmaxf(v0[e], 0.f), b = fmaxf(v1[e], 0.f); v0[e] = a * a; v1[e] = b * b; }
                    *(u32x4*)(hid + (size_t)row * 4096 + col0) = pack8(v0, v1);
                }
            }
    }
};
struct EpiFF2 {
    static constexpr bool PERM = true, AFTER_DRAIN = false;
    float* h; float* ss;
    __device__ __forceinline__ void operator()(const f32x4 (&acc)[2][2][4][2], const Unit& u, int wr, int wc, int fr, int fq) const {
        const int row0 = u.pm * BM + wr * 64 + fr;
#pragma unroll
        for (int ai = 0; ai < 2; ++ai)
#pragma unroll
            for (int m = 0; m < 4; ++m) {
                const int row = row0 + ai * HALF + m * 16; float sq = 0.f;
#pragma unroll
                for (int bj = 0; bj < 2; ++bj) {
                    const int col0 = u.pn * BM + bj * HALF + wc * 32 + 8 * fq; const size_t off = (size_t)row * 1024 + col0;
                    const f32x4 ha = *(const f32x4*)(h + off) + acc[ai][bj][m][0], hb = *(const f32x4*)(h + off + 4) + acc[ai][bj][m][1];
                    *(f32x4*)(h + off) = ha; *(f32x4*)(h + off + 4) = hb;
                    sq += (ha[0] * ha[0] + ha[1] * ha[1]) + (ha[2] * ha[2] + ha[3] * ha[3]) + (hb[0] * hb[0] + hb[1] * hb[1]) + (hb[2] * hb[2] + hb[3] * hb[3]);
                }
                asm volatile("s_nop 4" : "+v"(sq)); sq += __shfl_xor(sq, 16); asm volatile("s_nop 4" : "+v"(sq)); sq += __shfl_xor(sq, 32);
                if (fq == 0) atomicAdd(ss + row, sq);
            }
    }
};

template <class Epi, class Sched, bool ALIGN_EPI, bool SP2, int KC, int LDAC>
__device__ __forceinline__ void gemm_phase(PG8_LAS unsigned char* lds, const Gemm g, const Sched& S, const Epi& E) {
    int tid_ = threadIdx.x; asm volatile("" : "+v"(tid_)); const int tid = tid_, wid = __builtin_amdgcn_readfirstlane(tid >> 6), lane = tid & 63, wr = wid >> 2, wc = wid & 3, fr = lane & 15, fq = lane >> 4;
    constexpr int K = KC, nt = KC / BK, lda = LDAC;
    unsigned voffA[2], voffB[2];
#pragma unroll
    for (int i = 0; i < 2; ++i) { int R, C; stage_rc(tid * 16 + i * 8192, R, C); const int Rb = Epi::PERM ? ((R & ~31) + perm32(R & 31)) : R;
        voffA[i] = (unsigned)(R * lda + C) * 2u; voffB[i] = (unsigned)(Rb * K + C) * 2u; }
    const size_t kstep = (size_t)(BK * 2);
    const size_t hstepA = (size_t)HALF * lda * 2, hstepB = (size_t)HALF * K * 2;
    const size_t tstepA = 2 * hstepA, tstepB = 2 * hstepB;
    const unsigned ldsw = (unsigned)wid * 1024u;
    const int aoff = lds_byte(wr * 64 + fr, fq * 8), boff = lds_byte(wc * 32 + fr, fq * 8);
#define PG8_SA(b, h) (((b) * 2 + (h)) * HTB)
#define PG8_SB(b, h) ((4 + (b) * 2 + (h)) * HTB)
#define PG8_STAGE(bufoff, gbase, voff) do { _Pragma("unroll") for (int _i = 0; _i < 2; ++_i) \
        __builtin_amdgcn_global_load_lds((const unsigned*)((const char*)(gbase) + (voff)[_i]), (PG8_LAS unsigned*)(lds + (bufoff) + ldsw + _i * 8192), 16, 0, 0); } while (0)
#define PG8_LDA(dst, b, h) do { _Pragma("unroll") for (int m = 0; m < 4; ++m) _Pragma("unroll") for (int k = 0; k < 2; ++k) dst[m][k] = *(const PG8_LAS bf16x8*)(lds + PG8_SA(b, h) + aoff + m * 2048 + k * 1024); } while (0)
#define PG8_LDB(dst, b, h) do { _Pragma("unroll") for (int n = 0; n < 2; ++n) _Pragma("unroll") for (int k = 0; k < 2; ++k) dst[n][k] = *(const PG8_LAS bf16x8*)(lds + PG8_SB(b, h) + boff + n * 2048 + k * 1024); } while (0)
#define PG8_MMA(ai, bj, At, Bt) do { __builtin_amdgcn_s_setprio(1); _Pragma("unroll") for (int m = 0; m < 4; ++m) _Pragma("unroll") for (int n = 0; n < 2; ++n) _Pragma("unroll") for (int k = 0; k < 2; ++k) \
        acc[ai][bj][m][n] = __builtin_amdgcn_mfma_f32_16x16x32_bf16(Bt[n][k], At[m][k], acc[ai][bj][m][n], 0, 0, 0); __builtin_amdgcn_s_setprio(0); } while (0)
#define PG8_WAIT_V(n) asm volatile("s_waitcnt vmcnt(" #n ")" ::: "memory")
#define PG8_WAIT_L(n) asm volatile("s_waitcnt lgkmcnt(" #n ")" ::: "memory")
#define PG8_BAR __builtin_amdgcn_s_barrier()
#define PG8_SCHED __builtin_amdgcn_sched_barrier(0)
    Unit cur, nxt; int ui = 0;
    if (!S.next(0, cur)) return;
    f32x4 acc[2][2][4][2];
#pragma unroll
    for (int a = 0; a < 2; ++a)
#pragma unroll
        for (int b = 0; b < 2; ++b)
#pragma unroll
            for (int m = 0; m < 4; ++m)
#pragma unroll
                for (int n = 0; n < 2; ++n) acc[a][b][m][n] = (f32x4){0.f, 0.f, 0.f, 0.f};
    bf16x8 At[4][2], B0[2][2], B1[2][2];
    const char* cA = (const char*)g.A + (size_t)cur.pm * tstepA; const char* cB = (const char*)g.Bt + (size_t)cur.pn * tstepB;
    S.a_ready(cur);
    if constexpr (SP2) {
        PG8_STAGE(PG8_SB(0, 0), cB, voffB); PG8_STAGE(PG8_SB(0, 1), cB + hstepB, voffB); PG8_STAGE(PG8_SA(0, 0), cA, voffA); PG8_STAGE(PG8_SA(0, 1), cA + hstepA, voffA);
        if (wr == 1) PG8_BAR;
        PG8_WAIT_V(2); PG8_BAR;
        PG8_STAGE(PG8_SB(1, 0), cB + kstep, voffB); PG8_STAGE(PG8_SA(1, 0), cA + kstep, voffA); PG8_STAGE(PG8_SB(1, 1), cB + hstepB + kstep, voffB);
        PG8_WAIT_V(6); PG8_BAR;
    } else {
        PG8_STAGE(PG8_SB(0, 0), cB, voffB); PG8_STAGE(PG8_SA(0, 0), cA, voffA); PG8_STAGE(PG8_SB(0, 1), cB + hstepB, voffB); PG8_STAGE(PG8_SA(0, 1), cA + hstepA, voffA);
        if (wr == 1) PG8_BAR;
        PG8_WAIT_V(4); PG8_BAR;
        PG8_STAGE(PG8_SB(1, 0), cB + kstep, voffB); PG8_STAGE(PG8_SA(1, 0), cA + kstep, voffA); PG8_STAGE(PG8_SB(1, 1), cB + hstepB + kstep, voffB);
        PG8_WAIT_V(6); PG8_BAR;
    }
    for (;;) {
        const bool has_next = S.next(ui + 1, nxt);
        const char* nA = has_next ? (const char*)g.A + (size_t)nxt.pm * tstepA : cA; const char* nB = has_next ? (const char*)g.Bt + (size_t)nxt.pn * tstepB : cB;
        for (int t = 0; t < nt; t += 2) {
            const bool last = (t == nt - 2);
            const char* a1 = cA + (size_t)(t + 1) * kstep;
            const char* a2 = last ? nA : cA + (size_t)(t + 2) * kstep; const char* b2 = last ? nB : cB + (size_t)(t + 2) * kstep;
            const char* a3 = a2 + kstep; const char* b3 = b2 + kstep;
            if (last && has_next) S.a_ready(nxt);
            if constexpr (SP2) {
            PG8_LDB(B0, 0, 0); PG8_LDB(B1, 0, 1); PG8_SCHED; PG8_LDA(At, 0, 0); PG8_STAGE(PG8_SA(1, 1), a1 + hstepA, voffA);
            PG8_WAIT_V(8); PG8_WAIT_L(0); PG8_BAR; PG8_MMA(0, 0, At, B0); PG8_MMA(0, 1, At, B1); PG8_BAR; PG8_SCHED;
            PG8_LDA(At, 0, 1); PG8_STAGE(PG8_SB(0, 0), b2, voffB); PG8_STAGE(PG8_SB(0, 1), b2 + hstepB, voffB); PG8_STAGE(PG8_SA(0, 0), a2, voffA);
            PG8_WAIT_V(8); PG8_WAIT_L(0); PG8_BAR; PG8_MMA(1, 0, At, B0); PG8_MMA(1, 1, At, B1); PG8_BAR; PG8_SCHED;
            PG8_LDB(B0, 1, 0); PG8_LDB(B1, 1, 1); PG8_SCHED; PG8_LDA(At, 1, 0); PG8_STAGE(PG8_SA(0, 1), a2 + hstepA, voffA);
            PG8_WAIT_V(8); PG8_WAIT_L(0); PG8_BAR; PG8_MMA(0, 0, At, B0); PG8_MMA(0, 1, At, B1); PG8_BAR; PG8_SCHED;
            PG8_LDA(At, 1, 1); PG8_STAGE(PG8_SB(1, 0), b3, voffB); PG8_STAGE(PG8_SB(1, 1), b3 + hstepB, voffB); PG8_STAGE(PG8_SA(1, 0), a3, voffA);
            PG8_WAIT_V(8); PG8_WAIT_L(0); PG8_BAR; PG8_MMA(1, 0, At, B0); PG8_MMA(1, 1, At, B1); PG8_BAR; PG8_SCHED;
            } else {
            PG8_LDB(B0, 0, 0); PG8_SCHED; PG8_LDA(At, 0, 0); PG8_STAGE(PG8_SA(1, 1), a1 + hstepA, voffA);
            PG8_WAIT_L(8); PG8_BAR; PG8_WAIT_L(0); PG8_MMA(0, 0, At, B0); PG8_BAR; PG8_SCHED;
            PG8_LDB(B1, 0, 1); PG8_STAGE(PG8_SB(0, 0), b2, voffB);
            PG8_BAR; PG8_WAIT_L(0); PG8_MMA(0, 1, At, B1); PG8_BAR;
            PG8_LDA(At, 0, 1); PG8_STAGE(PG8_SA(0, 0), a2, voffA);
            PG8_BAR; PG8_WAIT_L(0); PG8_MMA(1, 0, At, B0); PG8_BAR; PG8_SCHED;
            PG8_STAGE(PG8_SB(0, 1), b2 + hstepB, voffB);
            PG8_WAIT_V(6); PG8_BAR; PG8_MMA(1, 1, At, B1); PG8_BAR;
            PG8_LDB(B0, 1, 0); PG8_SCHED; PG8_LDA(At, 1, 0); PG8_STAGE(PG8_SA(0, 1), a2 + hstepA, voffA);
            PG8_WAIT_L(8); PG8_BAR; PG8_WAIT_L(0); PG8_MMA(0, 0, At, B0); PG8_BAR; PG8_SCHED;
            PG8_LDB(B1, 1, 1); PG8_STAGE(PG8_SB(1, 0), b3, voffB);
            PG8_BAR; PG8_WAIT_L(0); PG8_MMA(0, 1, At, B1); PG8_BAR;
            PG8_LDA(At, 1, 1); PG8_STAGE(PG8_SA(1, 0), a3, voffA);
            PG8_BAR; PG8_WAIT_L(0); PG8_MMA(1, 0, At, B0); PG8_BAR; PG8_SCHED;
            PG8_STAGE(PG8_SB(1, 1), b3 + hstepB, voffB);
            PG8_WAIT_V(6); PG8_BAR; PG8_MMA(1, 1, At, B1); PG8_BAR;
            }
        }
        if constexpr (ALIGN_EPI) { if (wr == 0) PG8_BAR; }
        if constexpr (!Epi::AFTER_DRAIN) { E(acc, cur, wr, wc, fr, fq); S.done(cur); }
        if (!has_next) break;
#pragma unroll
        for (int a = 0; a < 2; ++a)
#pragma unroll
            for (int b = 0; b < 2; ++b)
#pragma unroll
                for (int m = 0; m < 4; ++m)
#pragma unroll
                    for (int n = 0; n < 2; ++n) acc[a][b][m][n] = (f32x4){0.f, 0.f, 0.f, 0.f};
        cur = nxt; cA = nA; cB = nB; ++ui;
        if constexpr (ALIGN_EPI) { if (wr == 1) PG8_BAR; }
    }
    PG8_WAIT_V(0);
    if constexpr (!ALIGN_EPI) { if (wr == 0) PG8_BAR; }
    PG8_BAR;
    if constexpr (Epi::AFTER_DRAIN) { E.fused(acc, cur, wr, wc, fr, fq, lds, wid, lane); S.done(cur); }
#undef PG8_SA
#undef PG8_SB
#undef PG8_STAGE
#undef PG8_LDA
#undef PG8_LDB
#undef PG8_MMA
#undef PG8_WAIT_V
#undef PG8_WAIT_L
#undef PG8_BAR
#undef PG8_SCHED
}
}

#define LAS __attribute__((address_space(3)))
typedef unsigned short bf16_t;
typedef unsigned u32x4 __attribute__((ext_vector_type(4)));
typedef unsigned u32x2 __attribute__((ext_vector_type(2)));
typedef float f32x4 __attribute__((ext_vector_type(4)));
typedef float f32x16 __attribute__((ext_vector_type(16)));
typedef short bf16x8 __attribute__((ext_vector_type(8)));
typedef short s16x4 __attribute__((ext_vector_type(4)));
using pg8::pk2;

constexpr int NT = 512;
constexpr int LDS_BYTES = 147456;
constexpr int M = 32768, D = 1024, SEQ = 4096, PW = 5888, FF = 4096;
constexpr size_t MiB = 1u << 20;
constexpr size_t SEC_QA = 0, SEC_KA = (size_t)M * 512, SEC_VA = (size_t)M * 640, SEC_QR = (size_t)M * 768, SEC_KR = (size_t)M * 1280, SEC_VR = (size_t)M * 1792, SEC_GR = (size_t)M * 2816, SEC_GB = (size_t)M * 4864;
constexpr size_t WS_WIN = 0, WS_WATT = 12 * MiB, WS_WRET = 13 * MiB, WS_WOUT = 15 * MiB, WS_W1 = 17 * MiB, WS_W2 = 25 * MiB;
constexpr size_t WS_TABA = 33 * MiB, WS_TABR = 34 * MiB, WS_SS1 = 36 * MiB, WS_SS2 = 36 * MiB + 512 * 1024;
constexpr size_t WS_CTL = 37 * MiB, CTL_BYTES = 16384;
constexpr int LDS_ST_OFF = LDS_BYTES - 16;
constexpr size_t WS_SX = 38 * MiB;
constexpr size_t WS_XN = 40 * MiB;
constexpr size_t WS_PROJ = 104 * MiB;
constexpr size_t WS_END = 472 * MiB;

struct Args { const float* in[13]; float* out; unsigned char* ws; };
#define XB_SYNC() xcd_barrier(xbar)

__device__ __forceinline__ float settle(float v) { asm volatile("s_nop 4" : "+v"(v)); return v; }
__device__ __forceinline__ float wave_sum(float v) {
#pragma unroll
    for (int o = 1; o < 64; o <<= 1) { v = settle(v); v += __shfl_xor(v, o); }
    return v;
}
__device__ __forceinline__ float ex2(float v) { return __builtin_amdgcn_exp2f(v); }
template <int CTRL> __device__ __forceinline__ float dpp_f(float v) { return __builtin_bit_cast(float, __builtin_amdgcn_update_dpp(0, __builtin_bit_cast(int, v), CTRL, 0xF, 0xF, false)); }
__device__ __forceinline__ float rsum16(float v) { v = settle(v); v += dpp_f<0xB1>(v); v = settle(v); v += dpp_f<0x4E>(v); v = settle(v); v += dpp_f<0x124>(v); v = settle(v); v += dpp_f<0x128>(v); return settle(v); }
__device__ __forceinline__ int crow(int r, int hi) { return (r & 3) + 8 * (r >> 2) + 4 * hi; }


#define XB_TMO      128
#define XB_XCNT(j)  (256  + 64 * (j))
#define XB_XSUB(j)  (1280 + 64 * (j))
#define XB_XGEN(j)  (2304 + 64 * (j))
#define XB_TOP      3328
#define XB_TOPGEN   3392
#define XCD_BAR_WORDS 3456
#define XB_SPIN_CAP (1u << 18)
__device__ __forceinline__ unsigned xb_ld(unsigned* p)              { return __hip_atomic_load(p, __ATOMIC_RELAXED, __HIP_MEMORY_SCOPE_AGENT); }
__device__ __forceinline__ unsigned xb_add(unsigned* p, unsigned v) { return __hip_atomic_fetch_add(p, v, __ATOMIC_RELAXED, __HIP_MEMORY_SCOPE_AGENT); }
__device__ __forceinline__ unsigned xb_xcc_id() { return (unsigned)__builtin_amdgcn_s_getreg((3 << 11) | 20) & 0xFu; }
#define XB_SPIN(cond, bar) do { unsigned _sp = 0; while (cond) { __builtin_amdgcn_s_sleep(1); \
    if ((++_sp & 255u) == 0u) { if (xb_ld(&(bar)[XB_TMO])) break; if (_sp > XB_SPIN_CAP) { atomicAdd(&(bar)[XB_TMO], 1u); break; } } } } while (0)
struct XcdBarrier { unsigned* bar; unsigned x; volatile LAS unsigned* st; };
__device__ __forceinline__ XcdBarrier xcd_barrier_post(unsigned* bar, volatile LAS unsigned* st) {
    XcdBarrier b; b.bar = bar; b.x = xb_xcc_id(); b.st = st;
    if (threadIdx.x == 0) (void)xb_add(&bar[XB_XCNT(b.x)], 1u);
    return b;
}
__device__ __forceinline__ void xcd_barrier_complete(unsigned* bar, unsigned x, unsigned& nloc, unsigned& nx) {
    const unsigned G = gridDim.x * gridDim.y * gridDim.z;
    unsigned sum, cnt, mine, sp = 0u;
    for (;;) {
        sum = 0u; cnt = 0u; mine = 0u;
#pragma unroll
        for (unsigned j = 0; j < 16; ++j) { const unsigned c = xb_ld(&bar[XB_XCNT(j)]); sum += c; cnt += (c > 0u) ? 1u : 0u; mine = (j == x) ? c : mine; }
        if (sum == G) break;
        __builtin_amdgcn_s_sleep(1);
        if ((++sp & 255u) == 0u) { if (xb_ld(&bar[XB_TMO])) break; if (sp > XB_SPIN_CAP) { atomicAdd(&bar[XB_TMO], 1u); break; } }
    }
    nloc = mine > 0u ? mine : 1u; nx = cnt > 0u ? cnt : 1u;
}
__device__ __forceinline__ void xcd_barrier(const XcdBarrier& b) {
    asm volatile("s_waitcnt vmcnt(0)" ::: "memory");
    __syncthreads();
    if (threadIdx.x == 0) {
        unsigned* bar = b.bar;
        __builtin_amdgcn_s_waitcnt(0);
        unsigned nloc = b.st[0], nx = b.st[1];
        if (nloc == 0u) { xcd_barrier_complete(bar, b.x, nloc, nx); b.st[0] = nloc; b.st[1] = nx; }
        const unsigned old = xb_add(&bar[XB_XSUB(b.x)], 1u);
        const unsigned gen = old / nloc;
        if (old + 1u == (gen + 1u) * nloc) {
            __builtin_amdgcn_fence(__ATOMIC_RELEASE, "agent");
            asm volatile("s_waitcnt vmcnt(0)" ::: "memory");
            const unsigned og = xb_add(&bar[XB_TOP], 1u);
            const unsigned tg = og / nx;
            if (og + 1u == (tg + 1u) * nx) xb_add(&bar[XB_TOPGEN], 1u);
            else XB_SPIN(xb_ld(&bar[XB_TOPGEN]) == tg, bar);
            __builtin_amdgcn_fence(__ATOMIC_ACQUIRE, "");
            asm volatile("s_waitcnt vmcnt(0)" ::: "memory");
            xb_add(&bar[XB_XGEN(b.x)], 1u);
        } else {
            XB_SPIN(xb_ld(&bar[XB_XGEN(b.x)]) == gen, bar);
            __builtin_amdgcn_fence(__ATOMIC_ACQUIRE, "agent");
            asm volatile("s_waitcnt vmcnt(0)" ::: "memory");
        }
    }
    __syncthreads();
}

__device__ __forceinline__ int src_col(int n) {
    if (n < 640) { const int p = n & 63; if (p < 16) { const int g = p >> 3, w = p & 7; return (n & ~63) + ((w < 4) ? (4 * g + w) : (8 + 4 * g + (w - 4))); } return n; }
    if (n >= 768 && n < 1792) { const int p = n & 127, g = p >> 3, w = p & 7; return (n & ~127) + ((w < 4) ? (4 * g + w) : (64 + 4 * g + (w - 4))); }
    return n;
}
__device__ __forceinline__ void p0_transpose_item(const float* W, int K, int N, bf16_t* WT, LAS float* scr, int item, int lane, bool perm) {
    const int nblk = N / 32, kb = item / nblk, nb = item % nblk, k0 = 64 * kb, n0 = 32 * nb;
    const int ncol = perm ? src_col(n0 + (lane & 31)) : (n0 + (lane & 31));
#pragma unroll
    for (int i = 0; i < 32; ++i) { const int kk = 2 * i + (lane >> 5); scr[kk * 33 + (lane & 31)] = W[(size_t)(k0 + kk) * N + ncol]; }
    asm volatile("s_waitcnt lgkmcnt(0)" ::: "memory");
    const int c = lane & 7;
#pragma unroll
    for (int j = 0; j < 4; ++j) { const int n = (lane >> 3) + 8 * j; const LAS float* s = scr + (8 * c) * 33 + n;
        u32x4 o; o.x = pk2(s[0 * 33], s[1 * 33]); o.y = pk2(s[2 * 33], s[3 * 33]); o.z = pk2(s[4 * 33], s[5 * 33]); o.w = pk2(s[6 * 33], s[7 * 33]);
        *(u32x4*)(WT + (size_t)(n0 + n) * K + k0 + 8 * c) = o; }
    asm volatile("s_waitcnt lgkmcnt(0)" ::: "memory");
}
__device__ __forceinline__ void rope_entry(float theta, int dim, int pos, int i, float* out2) {
    const float e = -(float)(2 * i) / (float)dim;
    const float inv_freq = (float)exp((double)e * log((double)theta));
    const float ang = (float)pos * inv_freq;
    const double a = (double)ang;
    const double qd = rint(a * 0.63661977236758134308);
    const double r = a - qd * 1.57079632679489661923, r2 = r * r;
    const double sn = r * (1.0 - r2 / 6.0 * (1.0 - r2 / 20.0 * (1.0 - r2 / 42.0 * (1.0 - r2 / 72.0 * (1.0 - r2 / 110.0 * (1.0 - r2 / 156.0))))));
    const double cs = 1.0 - r2 / 2.0 * (1.0 - r2 / 12.0 * (1.0 - r2 / 30.0 * (1.0 - r2 / 56.0 * (1.0 - r2 / 90.0 * (1.0 - r2 / 132.0 * (1.0 - r2 / 182.0))))));
    const int qq = ((int)qd) & 3;
    double c2 = cs, s2 = sn;
    if (qq == 1) { c2 = -sn; s2 = cs; } else if (qq == 2) { c2 = -cs; s2 = -sn; } else if (qq == 3) { c2 = sn; s2 = -cs; }
    out2[0] = (float)c2; out2[1] = (float)s2;
}

__device__ __forceinline__ void attn_unit(LAS unsigned char* lds, bf16_t* P, const float* sinks, int unit, int tid) {
    asm volatile("" : "+v"(tid));
    const int lane = tid & 63, w = __builtin_amdgcn_readfirstlane(tid >> 6), r32 = lane & 31, h = lane >> 5;
    const int blk = unit & 31, kvh = (unit >> 5) & 1, b = unit >> 6;
    const long rowbase = (long)b * SEQ + blk * 128;
    LAS unsigned char* Ks = lds;
    LAS unsigned short* Vt = (LAS unsigned short*)(lds + 36864);
#pragma unroll
    for (int i = 0; i < 4; ++i) {
        const int idx = tid + i * 512, key = idx & 255, ch = idx >> 8;
        const bool valid = (blk > 0) || (key >= 128);
        u32x4 kv = (u32x4){0u, 0u, 0u, 0u}, vv = kv;
        if (valid) { const size_t r = (size_t)(rowbase - 128 + key); kv = *(const u32x4*)(P + SEC_KA + r * 128 + kvh * 64 + ch * 8); vv = *(const u32x4*)(P + SEC_VA + r * 128 + kvh * 64 + ch * 8); }
        *(LAS u32x4*)(Ks + key * 144 + ch * 16) = kv;
        LAS unsigned short* vd = Vt + (ch * 8) * 260 + key;
        vd[0 * 260] = (unsigned short)(vv.x & 0xffffu); vd[1 * 260] = (unsigned short)(vv.x >> 16);
        vd[2 * 260] = (unsigned short)(vv.y & 0xffffu); vd[3 * 260] = (unsigned short)(vv.y >> 16);
        vd[4 * 260] = (unsigned short)(vv.z & 0xffffu); vd[5 * 260] = (unsigned short)(vv.z >> 16);
        vd[6 * 260] = (unsigned short)(vv.w & 0xffffu); vd[7 * 260] = (unsigned short)(vv.w >> 16);
    }
    __syncthreads();
    const int head = kvh * 4 + (w >> 1);
    const float sink = sinks[head];
#pragma unroll 1
    for (int hf = 0; hf < 2; ++hf) {
        const int r0 = (w & 1) * 64 + hf * 32;
        const bf16_t* qptr = P + SEC_QA + (size_t)(rowbase + r0 + r32) * 512 + head * 64 + 8 * h;
        bf16x8 qf[4];
#pragma unroll
        for (int s = 0; s < 4; ++s) qf[s] = *(const bf16x8*)(qptr + 16 * s);
        f32x16 x[5];
#pragma unroll
        for (int kt = 0; kt < 5; ++kt) {
            f32x16 a0;
#pragma unroll
            for (int i = 0; i < 16; ++i) a0[i] = 0.f;
#pragma unroll
            for (int s = 0; s < 4; ++s) { const bf16x8 a = *(const LAS bf16x8*)(Ks + (r0 + kt * 32 + r32) * 144 + (16 * s + 8 * h) * 2); a0 = __builtin_amdgcn_mfma_f32_32x32x16_bf16(a, qf[s], a0, 0, 0, 0); }
            x[kt] = a0;
        }
        const int qi = r0 + r32;
        float mx = sink;
#pragma unroll
        for (int kt = 0; kt < 5; ++kt)
#pragma unroll
            for (int i = 0; i < 16; ++i) { const int f = r0 + kt * 32 + crow(i, h); const bool ok = (f > qi) && (f <= qi + 128) && ((blk > 0) || (f >= 128)); const float v = ok ? x[kt][i] : -1e30f; x[kt][i] = v; mx = fmaxf(mx, v); }
        mx = settle(mx); mx = fmaxf(mx, __shfl_xor(mx, 32));
        float l = 0.f;
#pragma unroll
        for (int kt = 0; kt < 5; ++kt)
#pragma unroll
            for (int i = 0; i < 16; ++i) { const float e = __expf(x[kt][i] - mx); x[kt][i] = e; l += e; }
        l = settle(l); l += __shfl_xor(l, 32); l += __expf(sink - mx);
        const float inv = 1.0f / l;
        f32x16 o[2];
#pragma unroll
        for (int i = 0; i < 16; ++i) { o[0][i] = 0.f; o[1][i] = 0.f; }
#pragma unroll
        for (int kt = 0; kt < 5; ++kt)
#pragma unroll
            for (int s2 = 0; s2 < 2; ++s2) {
                u32x4 pw; pw.x = pk2(x[kt][8 * s2 + 0] * inv, x[kt][8 * s2 + 1] * inv); pw.y = pk2(x[kt][8 * s2 + 2] * inv, x[kt][8 * s2 + 3] * inv);
                pw.z = pk2(x[kt][8 * s2 + 4] * inv, x[kt][8 * s2 + 5] * inv); pw.w = pk2(x[kt][8 * s2 + 6] * inv, x[kt][8 * s2 + 7] * inv);
                const bf16x8 pa = __builtin_bit_cast(bf16x8, pw);
#pragma unroll
                for (int dt = 0; dt < 2; ++dt) {
                    const LAS unsigned short* vb = Vt + (32 * dt + r32) * 260 + r0 + kt * 32 + 16 * s2 + 4 * h;
                    const s16x4 lo = *(const LAS s16x4*)vb, hi = *(const LAS s16x4*)(vb + 8);
                    const bf16x8 vf = __builtin_shufflevector(lo, hi, 0, 1, 2, 3, 4, 5, 6, 7);
                    o[dt] = __builtin_amdgcn_mfma_f32_32x32x16_bf16(pa, vf, o[dt], 0, 0, 0);
                }
            }
#pragma unroll
        for (int dt = 0; dt < 2; ++dt)
#pragma unroll
            for (int i = 0; i < 16; ++i) { const unsigned wv = pk2(o[dt][i], 0.f); P[SEC_QA + (size_t)(rowbase + r0 + crow(i, h)) * 512 + head * 64 + 32 * dt + r32] = (bf16_t)(wv & 0xffffu); }
    }
    __syncthreads();
}

__device__ __forceinline__ void scan_unit(LAS unsigned char* lds, const bf16_t* P, bf16_t* ST, int unit, int tid) {
    asm volatile("" : "+v"(tid));
    const int lane = tid & 63, w = __builtin_amdgcn_readfirstlane(tid >> 6), l15 = lane & 15, q = lane >> 4;
    const int sl = unit & 7, hh = (unit >> 3) & 3, b = unit >> 5;
    const float lg2 = log1pf(-exp2f(-5.0f - (float)hh)) * 1.4426950408889634f;
    const float cdec = ex2(128.0f * lg2);
    LAS unsigned short* Kt = (LAS unsigned short*)lds;
    LAS unsigned short* Vt = Kt + 128 * 128;
    f32x4 acc[2]; acc[0] = (f32x4){0.f, 0.f, 0.f, 0.f}; acc[1] = acc[0];
    const size_t row0 = (size_t)b * SEQ;
    const int kkey0 = tid >> 4, kch = tid & 15, vkey = tid >> 2, vch = tid & 3;
    const bf16_t* kbase = P + SEC_KR + (row0 + kkey0) * 512 + hh * 128 + kch * 8;
    const bf16_t* vbase = P + SEC_VR + (row0 + vkey) * 1024 + hh * 256 + sl * 32 + vch * 8;
    float dec[4];
#pragma unroll
    for (int i = 0; i < 4; ++i) dec[i] = ex2((float)(127 - (kkey0 + 32 * i)) * lg2);
    u32x4 kA[4], vA, kB[4], vB, kC[4], vC, kD[4], vD;
#pragma unroll
    for (int i = 0; i < 4; ++i) { kA[i] = *(const u32x4*)(kbase + (size_t)(32 * i) * 512); kB[i] = *(const u32x4*)(kbase + (size_t)(128 + 32 * i) * 512);
                                  kC[i] = *(const u32x4*)(kbase + (size_t)(256 + 32 * i) * 512); kD[i] = *(const u32x4*)(kbase + (size_t)(384 + 32 * i) * 512); }
    vA = *(const u32x4*)vbase; vB = *(const u32x4*)(vbase + (size_t)128 * 1024); vC = *(const u32x4*)(vbase + (size_t)256 * 1024); vD = *(const u32x4*)(vbase + (size_t)384 * 1024);
    int kpos[8], vpos[8];
#pragma unroll
    for (int e = 0; e < 8; ++e) { const int dk = 8 * kch + e, dv = 8 * vch + e;
        kpos[e] = dk * 128 + ((((kkey0 >> 3) ^ ((dk ^ kch) & 15)) & 15) << 3) + (kkey0 & 7);
        vpos[e] = dv * 128 + ((((vkey >> 3) ^ ((dv ^ vch) & 15)) & 15) << 3) + (vkey & 7); }
    const int rk = 16 * w + l15, gk = (rk ^ (rk >> 3)) & 15, gv0 = (l15 ^ (l15 >> 3)) & 15, gv1 = ((16 + l15) ^ ((16 + l15) >> 3)) & 15;
#define SCAN_STEP(c, KR, VR) do { \
        _Pragma("unroll") for (int tc = 0; tc < 2; ++tc) { u32x2 wv; wv.x = pk2(acc[tc][0], acc[tc][1]); wv.y = pk2(acc[tc][2], acc[tc][3]); \
            *(u32x2*)(ST + ((size_t)((b * 4 + hh) * 32 + (c)) * 256 + sl * 32 + tc * 16 + l15) * 128 + 16 * w + 4 * q) = wv; } \
        __syncthreads(); \
        _Pragma("unroll") for (int i = 0; i < 4; ++i) { const u32x4 kv = KR[i]; const float dc = dec[i]; unsigned t; \
              \
            t = pk2(pg8::bflo(kv.x) * dc, pg8::bfhi(kv.x) * dc); Kt[kpw(kpos[0], i)] = (unsigned short)(t & 0xffffu); Kt[kpw(kpos[1], i)] = (unsigned short)(t >> 16); \
            t = pk2(pg8::bflo(kv.y) * dc, pg8::bfhi(kv.y) * dc); Kt[kpw(kpos[2], i)] = (unsigned short)(t & 0xffffu); Kt[kpw(kpos[3], i)] = (unsigned short)(t >> 16); \
            t = pk2(pg8::bflo(kv.z) * dc, pg8::bfhi(kv.z) * dc); Kt[kpw(kpos[4], i)] = (unsigned short)(t & 0xffffu); Kt[kpw(kpos[5], i)] = (unsigned short)(t >> 16); \
            t = pk2(pg8::bflo(kv.w) * dc, pg8::bfhi(kv.w) * dc); Kt[kpw(kpos[6], i)] = (unsigned short)(t & 0xffffu); Kt[kpw(kpos[7], i)] = (unsigned short)(t >> 16); } \
        { Vt[vpos[0]] = (unsigned short)(VR.x & 0xffffu); Vt[vpos[1]] = (unsigned short)(VR.x >> 16); \
          Vt[vpos[2]] = (unsigned short)(VR.y & 0xffffu); Vt[vpos[3]] = (unsigned short)(VR.y >> 16); \
          Vt[vpos[4]] = (unsigned short)(VR.z & 0xffffu); Vt[vpos[5]] = (unsigned short)(VR.z >> 16); \
          Vt[vpos[6]] = (unsigned short)(VR.w & 0xffffu); Vt[vpos[7]] = (unsigned short)(VR.w >> 16); } \
        if ((c) + 4 < 32) { const size_t offr = (size_t)((c) + 4) * 128; \
            _Pragma("unroll") for (int i = 0; i < 4; ++i) KR[i] = *(const u32x4*)(kbase + (offr + 32 * i) * 512); \
            VR = *(const u32x4*)(vbase + offr * 1024); } \
        __syncthreads(); \
        acc[0] = acc[0] * cdec; acc[1] = acc[1] * cdec; \
        _Pragma("unroll") for (int s = 0; s < 4; ++s) { \
            const bf16x8 a = *(const LAS bf16x8*)(Kt + rk * 128 + (((4 * s + q) ^ gk) << 3)); \
            const bf16x8 b0 = *(const LAS bf16x8*)(Vt + l15 * 128 + (((4 * s + q) ^ gv0) << 3)); \
            const bf16x8 b1 = *(const LAS bf16x8*)(Vt + (16 + l15) * 128 + (((4 * s + q) ^ gv1) << 3)); \
            acc[0] = __builtin_amdgcn_mfma_f32_16x16x32_bf16(a, b0, acc[0], 0, 0, 0); acc[1] = __builtin_amdgcn_mfma_f32_16x16x32_bf16(a, b1, acc[1], 0, 0, 0); } \
    } while (0)
#define kpw(pos, i) ((pos) ^ ((4 * (i)) << 3))
#pragma unroll 1
    for (int c = 0; c < 32; c += 4) { SCAN_STEP(c, kA, vA); SCAN_STEP(c + 1, kB, vB); SCAN_STEP(c + 2, kC, vC); SCAN_STEP(c + 3, kD, vD); }
#undef SCAN_STEP
#undef kpw
    __syncthreads();
}

__device__ __forceinline__ void pos0_partial(LAS unsigned char* lds, const float* x, const float* gmix, const float* win, float* sx, int item, int tid) {
    const int part = item & 3, hh = (item >> 2) & 3, b = item >> 4;
    LAS float* xg = (LAS float*)(lds + 137216);
    LAS float* hp = xg + 256;
    if (tid < 256) { const int k = part * 256 + tid; xg[tid] = x[(size_t)b * SEQ * D + k] * gmix[k]; }
    __syncthreads();
    const int d2 = tid & 255, kh = tid >> 8;
    const float* wp = win + (size_t)(part * 256 + kh * 128) * PW + (d2 < 128 ? 768 + hh * 128 + d2 : 1280 + hh * 128 + (d2 - 128));
    float acc = 0.f;
#pragma unroll 32
    for (int k = 0; k < 128; ++k) acc += xg[kh * 128 + k] * wp[(size_t)k * PW];
    hp[kh * 256 + d2] = acc;
    __syncthreads();
    if (tid < 256) sx[(size_t)item * 256 + tid] = hp[tid] + hp[256 + tid];
    __syncthreads();
}

__device__ __forceinline__ void retout_unit(LAS unsigned char* lds, bf16_t* P, const bf16_t* ST, const float* gn, int unit, int tid, const float* x, const float* sx) {
    asm volatile("" : "+v"(tid));
    const int lane = tid & 63, w = __builtin_amdgcn_readfirstlane(tid >> 6), l15 = lane & 15, q = lane >> 4;
    const int c = unit & 31, hh = (unit >> 5) & 3, b = unit >> 7;
    const size_t rowc = (size_t)b * SEQ + c * 128;
    const float lg2 = log1pf(-exp2f(-5.0f - (float)hh)) * 1.4426950408889634f;
    float s_exact = 0.f;
    if (c == 0) {
        LAS float* red = (LAS float*)(lds + 137216);
        const float* xrow = x + rowc * D;
        float ssq = 0.f;
#pragma unroll
        for (int k = tid; k < 1024; k += 512) { const float xv = xrow[k]; ssq += xv * xv; }
        ssq = wave_sum(ssq); if (lane == 0) red[w] = ssq;
        if (tid < 128) { const float* sp = sx + (size_t)((b * 4 + hh) * 4) * 256 + tid;
                         const float qs = (sp[0] + sp[256]) + (sp[512] + sp[768]), ks = (sp[128] + sp[384]) + (sp[640] + sp[896]);
                         const float pr = wave_sum(qs * ks); if (lane == 0) red[8 + w] = pr; }
        __syncthreads();
        float tot = 0.f;
#pragma unroll
        for (int i = 0; i < 8; ++i) tot += red[i];
        const float rs = rsqrtf(tot * (1.0f / D) + 1e-6f);
        s_exact = (red[8] + red[9]) * rs * rs * 0.08838834764831845f;
    }
    LAS unsigned short* RA = (LAS unsigned short*)lds;
    LAS unsigned short* Ks = (LAS unsigned short*)(lds + 69632);
    const bf16_t* st = ST + (size_t)((b * 4 + hh) * 32 + c) * 32768;
    if (c != 0)
#pragma unroll
    for (int i = 0; i < 8; ++i) { const int idx = tid + i * 512, dv = idx >> 4, ch = idx & 15; *(LAS u32x4*)(RA + dv * 136 + ch * 8) = *(const u32x4*)(st + dv * 128 + ch * 8); }
#pragma unroll
    for (int i = 0; i < 4; ++i) { const int idx = tid + i * 512, key = idx >> 4, ch = idx & 15; *(LAS u32x4*)(Ks + key * 136 + ch * 8) = *(const u32x4*)(P + SEC_KR + (rowc + key) * 512 + hh * 128 + ch * 8); }
    u32x4 vreg[8];
#pragma unroll
    for (int i = 0; i < 8; ++i) { const int idx = tid + i * 512, key = idx & 127, ch = idx >> 7; vreg[i] = *(const u32x4*)(P + SEC_VR + (rowc + key) * 1024 + hh * 256 + ch * 8); }
    bf16x8 qf[4];
#pragma unroll
    for (int s = 0; s < 4; ++s) qf[s] = *(const bf16x8*)(P + SEC_QR + (rowc + 16 * w + l15) * 512 + hh * 128 + 32 * s + 8 * q);
    __syncthreads();
    f32x4 acc[16];
#pragma unroll
    for (int n = 0; n < 16; ++n) {
        f32x4 a0 = (f32x4){0.f, 0.f, 0.f, 0.f};
#pragma unroll
        for (int s = 0; s < (c == 0 ? 0 : 4); ++s) a0 = __builtin_amdgcn_mfma_f32_16x16x32_bf16(qf[s], *(const LAS bf16x8*)(RA + (16 * n + l15) * 136 + 32 * s + 8 * q), a0, 0, 0, 0);
        acc[n] = a0;
    }
    {
        f32x4 qd;
#pragma unroll
        for (int j = 0; j < 4; ++j) qd[j] = ex2((float)(16 * w + 4 * q + j + 1) * lg2);
#pragma unroll
        for (int n = 0; n < 16; ++n) acc[n] = acc[n] * qd;
    }
    f32x4 xt[8];
#pragma unroll
    for (int t = 0; t < 8; ++t) {
        f32x4 a0 = (f32x4){0.f, 0.f, 0.f, 0.f};
        if (t <= w) {
#pragma unroll
            for (int s = 0; s < 4; ++s) a0 = __builtin_amdgcn_mfma_f32_16x16x32_bf16(*(const LAS bf16x8*)(Ks + (16 * t + l15) * 136 + 32 * s + 8 * q), qf[s], a0, 0, 0, 0);
            if (t == 0 && c == 0 && w == 0 && lane == 0) a0[0] = s_exact;
#pragma unroll
            for (int j = 0; j < 4; ++j) { const int d = (16 * w + l15) - (16 * t + 4 * q + j); a0[j] = (d >= 0) ? a0[j] * ex2((float)d * lg2) : 0.f; }
        }
        xt[t] = a0;
    }
    __syncthreads();
#pragma unroll
    for (int i = 0; i < 8; ++i) { const int idx = tid + i * 512, key = idx & 127, ch = idx >> 7; LAS unsigned short* vd = RA + (ch * 8) * 132 + key; const u32x4 vv = vreg[i];
        vd[0 * 132] = (unsigned short)(vv.x & 0xffffu); vd[1 * 132] = (unsigned short)(vv.x >> 16);
        vd[2 * 132] = (unsigned short)(vv.y & 0xffffu); vd[3 * 132] = (unsigned short)(vv.y >> 16);
        vd[4 * 132] = (unsigned short)(vv.z & 0xffffu); vd[5 * 132] = (unsigned short)(vv.z >> 16);
        vd[6 * 132] = (unsigned short)(vv.w & 0xffffu); vd[7 * 132] = (unsigned short)(vv.w >> 16); }
    __syncthreads();
#pragma unroll
    for (int u = 0; u < 4; ++u) {
        if (2 * u <= w) {
            u32x4 pw; pw.x = pk2(xt[2 * u][0], xt[2 * u][1]); pw.y = pk2(xt[2 * u][2], xt[2 * u][3]); pw.z = pk2(xt[2 * u + 1][0], xt[2 * u + 1][1]); pw.w = pk2(xt[2 * u + 1][2], xt[2 * u + 1][3]);
            const bf16x8 pa = __builtin_bit_cast(bf16x8, pw);
#pragma unroll
            for (int n = 0; n < 16; ++n) {
                const LAS unsigned short* vb = RA + (16 * n + l15) * 132 + 32 * u + 4 * q;
                const s16x4 lo = *(const LAS s16x4*)vb, hi = *(const LAS s16x4*)(vb + 16);
                const bf16x8 vf = __builtin_shufflevector(lo, hi, 0, 1, 2, 3, 4, 5, 6, 7);
                acc[n] = __builtin_amdgcn_mfma_f32_16x16x32_bf16(pa, vf, acc[n], 0, 0, 0);
            }
        }
    }
    LAS unsigned short* Yw = (LAS unsigned short*)(lds + 69632) + w * (16 * 264);
    float gnv[16];
#pragma unroll
    for (int n = 0; n < 16; ++n) gnv[n] = gn[hh * 256 + 16 * n + l15];
#pragma unroll
    for (int j = 0; j < 4; ++j) {
        float s = 0.f;
#pragma unroll
        for (int n = 0; n < 16; ++n) s += acc[n][j];
        s = rsum16(s);
        const float mu = s * (1.0f / 256.0f);
        float v = 0.f;
#pragma unroll
        for (int n = 0; n < 16; ++n) { const float d = acc[n][j] - mu; v += d * d; }
        v = rsum16(v);
        const float rstd = rsqrtf(v * (1.0f / 256.0f) + 1e-6f);
#pragma unroll
        for (int n = 0; n < 16; ++n) { const float yn = (acc[n][j] - mu) * rstd * gnv[n]; Yw[(4 * q + j) * 264 + 16 * n + l15] = (unsigned short)(pk2(yn, 0.f) & 0xffffu); }
    }
    {
        u32x4 gq[8]; bf16_t* gp[8];
#pragma unroll
        for (int k = 0; k < 8; ++k) { const int id = lane + 64 * k, row = id >> 5, ch = id & 31; gp[k] = P + SEC_GR + (rowc + 16 * w + row) * 1024 + hh * 256 + ch * 8; gq[k] = *(const u32x4*)gp[k]; }
#pragma unroll
        for (int k = 0; k < 8; ++k) { const int id = lane + 64 * k, row = id >> 5, ch = id & 31;
            const u32x4 yv = *(const LAS u32x4*)(Yw + row * 264 + ch * 8); const u32x4 g = gq[k]; u32x4 o;
            o.x = pk2(pg8::bflo(yv.x) * pg8::bflo(g.x), pg8::bfhi(yv.x) * pg8::bfhi(g.x)); o.y = pk2(pg8::bflo(yv.y) * pg8::bflo(g.y), pg8::bfhi(yv.y) * pg8::bfhi(g.y));
            o.z = pk2(pg8::bflo(yv.z) * pg8::bflo(g.z), pg8::bfhi(yv.z) * pg8::bfhi(g.z)); o.w = pk2(pg8::bflo(yv.w) * pg8::bflo(g.w), pg8::bfhi(yv.w) * pg8::bfhi(g.w));
            *(u32x4*)gp[k] = o; }
    }
    __syncthreads();
}

__global__ void __launch_bounds__(NT, 2) mega(Args a) {
    extern __shared__ __attribute__((aligned(16))) unsigned char lds_raw[];
    LAS unsigned char* lds = (LAS unsigned char*)lds_raw;
    cg::grid_group grid = cg::this_grid();
    const int tid = threadIdx.x, lane = tid & 63, wave = __builtin_amdgcn_readfirstlane(tid >> 6);
    const int G = gridDim.x, bid = blockIdx.x;
    const int gw = bid * 8 + wave, NGW = G * 8;
    unsigned char* ws = a.ws;
    const float* x = a.in[0];
    bf16_t* WinT = (bf16_t*)(ws + WS_WIN); bf16_t* WattT = (bf16_t*)(ws + WS_WATT); bf16_t* WretT = (bf16_t*)(ws + WS_WRET); bf16_t* WoutT = (bf16_t*)(ws + WS_WOUT);
    bf16_t* W1T = (bf16_t*)(ws + WS_W1); bf16_t* W2T = (bf16_t*)(ws + WS_W2);
    float* tabA = (float*)(ws + WS_TABA); float* tabR = (float*)(ws + WS_TABR); float* ss1 = (float*)(ws + WS_SS1); float* ss2 = (float*)(ws + WS_SS2);
    bf16_t* XN = (bf16_t*)(ws + WS_XN); bf16_t* STATE = (bf16_t*)a.out; bf16_t* XN2 = XN;
    bf16_t* PROJ = (bf16_t*)(ws + WS_PROJ); bf16_t* HID = PROJ;
    volatile LAS unsigned* xb_st = (volatile LAS unsigned*)(lds + LDS_ST_OFF);
    if (tid < 2) xb_st[tid] = 0u;
    __syncthreads();
    if (bid == 0) { unsigned* ctl = (unsigned*)(ws + WS_CTL);
#pragma unroll
        for (int i = tid; i < (int)(CTL_BYTES / 4); i += NT) __hip_atomic_store(ctl + i, 0u, __ATOMIC_RELAXED, __HIP_MEMORY_SCOPE_AGENT); }
    asm volatile("s_waitcnt vmcnt(0)" ::: "memory");
    __syncthreads();
    grid.sync();
    const XcdBarrier xbar = xcd_barrier_post((unsigned*)(ws + WS_CTL), xb_st);
    {
        LAS float* scr = (LAS float*)(lds + wave * 16384);
        constexpr int I_IN = 16 * 184;
        for (int it = gw; it < I_IN; it += NGW) p0_transpose_item(a.in[2], 1024, 5888, WinT, scr, it, lane, true);
        const f32x4* gp = (const f32x4*)a.in[1] + lane;
        f32x4 gv[4];
#pragma unroll
        for (int j = 0; j < 4; ++j) gv[j] = gp[64 * j];
        for (int m = gw; m < M; m += 2 * NGW) {
            const int m2 = m + NGW;
            const f32x4* xr = (const f32x4*)(x + (size_t)m * D) + lane;
            const f32x4* xr2 = (const f32x4*)(x + (size_t)(m2 < M ? m2 : m) * D) + lane;
            f32x4 v[4], u[4]; float s = 0.f, s2 = 0.f;
#pragma unroll
            for (int j = 0; j < 4; ++j) { v[j] = xr[64 * j]; u[j] = xr2[64 * j]; }
#pragma unroll
            for (int j = 0; j < 4; ++j) { s += (v[j][0] * v[j][0] + v[j][1] * v[j][1]) + (v[j][2] * v[j][2] + v[j][3] * v[j][3]); s2 += (u[j][0] * u[j][0] + u[j][1] * u[j][1]) + (u[j][2] * u[j][2] + u[j][3] * u[j][3]); }
            const float rs = rsqrtf(wave_sum(s) * (1.0f / D) + 1e-6f), rs2 = rsqrtf(wave_sum(s2) * (1.0f / D) + 1e-6f);
            u32x2* o8 = (u32x2*)(XN + (size_t)m * D) + lane;
#pragma unroll
            for (int j = 0; j < 4; ++j) { u32x2 o; o.x = pk2(v[j][0] * rs * gv[j][0], v[j][1] * rs * gv[j][1]); o.y = pk2(v[j][2] * rs * gv[j][2], v[j][3] * rs * gv[j][3]); o8[64 * j] = o; }
            if (m2 < M) { u32x2* o9 = (u32x2*)(XN + (size_t)m2 * D) + lane;
#pragma unroll
                for (int j = 0; j < 4; ++j) { u32x2 o; o.x = pk2(u[j][0] * rs2 * gv[j][0], u[j][1] * rs2 * gv[j][1]); o.y = pk2(u[j][2] * rs2 * gv[j][2], u[j][3] * rs2 * gv[j][3]); o9[64 * j] = o; } }
        }
        const int gt = bid * NT + tid, NGT = G * NT;
        for (int e = gt; e < SEQ * 8; e += NGT) rope_entry(500000.0f, 16, e >> 3, e & 7, tabA + 2 * e);
        for (int e = gt; e < SEQ * 64; e += NGT) rope_entry(10000.0f, 128, e >> 6, e & 63, tabR + 2 * e);
        for (int e = gt; e < M; e += NGT) { ss1[e] = 0.f; ss2[e] = 0.f; }
    }
    XB_SYNC();
    {
        pg8::Gemm g{XN, WinT, M, PW, 1024, 1024}; pg8::StaticOrder S; S.init(M, PW, G, bid);
        pg8::EpiProj E{PROJ, a.in[3], tabA, tabR};
        pg8::gemm_phase<pg8::EpiProj, pg8::StaticOrder, true, true, 1024, 1024>(lds, g, S, E);
        {
            int nidle = 0, rank = -1;
            const int nwg = (M / 256) * (PW / 256), nr = (nwg + G - 1) / G, first_idle = nwg - (nr - 1) * G;
            if (first_idle < G) { nidle = G - first_idle; rank = bid - first_idle; } else { nidle = G; rank = bid; }
            if (rank >= 0) {
                LAS float* scr = (LAS float*)(lds + wave * 16384);
                constexpr int I_ATT = 8 * 32, I_RET = 16 * 32, I_OUT = 16 * 32, I_1 = 16 * 128, I_2 = 64 * 32, NLATE = I_ATT + I_RET + I_OUT + I_1 + I_2;
                for (int it = rank * 8 + wave; it < NLATE; it += nidle * 8) {
                    int r = it;
                    if (r < I_ATT) { p0_transpose_item(a.in[6], 512, 1024, WattT, scr, r, lane, false); continue; } r -= I_ATT;
                    if (r < I_RET) { p0_transpose_item(a.in[7], 1024, 1024, WretT, scr, r, lane, false); continue; } r -= I_RET;
                    if (r < I_OUT) { p0_transpose_item(a.in[8], 1024, 1024, WoutT, scr, r, lane, false); continue; } r -= I_OUT;
                    if (r < I_1) { p0_transpose_item(a.in[10], 1024, 4096, W1T, scr, r, lane, false); continue; } r -= I_1;
                    p0_transpose_item(a.in[11], 4096, 1024, W2T, scr, r, lane, false);
                }
                for (int it = rank; it < 128; it += nidle) pos0_partial(lds, x, a.in[1], a.in[2], (float*)(ws + WS_SX), it, tid);
            }
        }
    }
    XB_SYNC();
    {
        for (int u = bid; u < 768; u += G) {
            if (u < 256) { const int su = (G == 256) ? ((((u & 7) * 4 + ((u >> 3) >> 3)) << 3) | ((u >> 3) & 7)) : u; scan_unit(lds, PROJ, STATE, su, tid); }
            else attn_unit(lds, PROJ, a.in[4], u - 256, tid);
        }
    }
    XB_SYNC();
    for (int u = bid; u < 1024; u += G) retout_unit(lds, PROJ, STATE, a.in[5], u, tid, x, (const float*)(ws + WS_SX));
    XB_SYNC();
    {
        pg8::StaticOrder S; S.init(M, 1024, G, bid);
        { pg8::Gemm g{PROJ + SEC_QA, WattT, M, 1024, 512, 512}; pg8::EpiGateA E{PROJ}; pg8::gemm_phase<pg8::EpiGateA, pg8::StaticOrder, true, true, 512, 512>(lds, g, S, E); }
        { pg8::Gemm g{PROJ + SEC_GR, WretT, M, 1024, 1024, 1024}; pg8::EpiMerge E{PROJ}; pg8::gemm_phase<pg8::EpiMerge, pg8::StaticOrder, true, true, 1024, 1024>(lds, g, S, E); }
    }
    XB_SYNC();
    {
        pg8::StaticOrder S; S.init(M, 1024, G, bid);
        pg8::Gemm g{PROJ + SEC_GB, WoutT, M, 1024, 1024, 1024}; pg8::EpiOut E{x, a.out, XN2, a.in[9], ss1};
        pg8::gemm_phase<pg8::EpiOut, pg8::StaticOrder, true, true, 1024, 1024>(lds, g, S, E);
    }
    XB_SYNC();
    {
        pg8::StaticOrder S; S.init(M, FF, G, bid);
        pg8::Gemm g{XN2, W1T, M, FF, 1024, 1024}; pg8::EpiFF1 E{HID, ss1};
        pg8::gemm_phase<pg8::EpiFF1, pg8::StaticOrder, true, true, 1024, 1024>(lds, g, S, E);
    }
    XB_SYNC();
    {
        pg8::StaticOrder S; S.init(M, 1024, G, bid);
        pg8::Gemm g{HID, W2T, M, 1024, FF, FF}; pg8::EpiFF2 E{a.out, ss2};
        pg8::gemm_phase<pg8::EpiFF2, pg8::StaticOrder, true, true, FF, FF>(lds, g, S, E);
    }
    XB_SYNC();
    {
        int tid8 = threadIdx.x; asm volatile("" : "+v"(tid8)); int bid8 = blockIdx.x, G8 = gridDim.x; asm volatile("" : "+s"(bid8), "+s"(G8));
        const int lane = tid8 & 63, gw = bid8 * 8 + __builtin_amdgcn_readfirstlane(tid8 >> 6), NGW = G8 * 8;
        const f32x4* gp = (const f32x4*)a.in[12] + lane;
        f32x4 gv[4];
#pragma unroll
        for (int j = 0; j < 4; ++j) gv[j] = gp[64 * j];
        for (int m = gw; m < M; m += NGW) {
            const float rs = rsqrtf(ss2[m] * (1.0f / D) + 1e-6f);
            f32x4* xr = (f32x4*)(a.out + (size_t)m * D) + lane;
#pragma unroll
            for (int j = 0; j < 4; ++j) { f32x4 v = xr[64 * j]; v = v * rs * gv[j]; xr[64 * j] = v; }
        }
    }
}

extern "C" void kernel_launch(void* const* d_in, const int* in_sizes, int n_in, void* d_out, int out_size, void* d_ws, size_t ws_size, hipStream_t stream) {
    static int grid_blocks = 0;
    if (!grid_blocks) {
        if (n_in != 13 || in_sizes[0] != M * D || out_size != M * D || ws_size < WS_END) { fprintf(stderr, "kernel_launch: unexpected shapes / workspace (n_in %d, in0 %d, out %d, ws %zu)\n", n_in, n_in > 0 ? in_sizes[0] : -1, out_size, ws_size); grid_blocks = -1; return; }
        int dev = 0, cus = 0, per_cu = 0;
        hipGetDevice(&dev);
        hipDeviceGetAttribute(&cus, hipDeviceAttributeMultiprocessorCount, dev);
        hipFuncSetAttribute((const void*)mega, hipFuncAttributeMaxDynamicSharedMemorySize, LDS_BYTES);
        hipOccupancyMaxActiveBlocksPerMultiprocessor(&per_cu, (const void*)mega, NT, LDS_BYTES);
        if (per_cu < 1) { fprintf(stderr, "kernel_launch: occupancy query says %d blocks per CU\n", per_cu); per_cu = 1; }
        grid_blocks = cus;
    }
    if (grid_blocks < 0) return;
    Args a{};
    for (int i = 0; i < 13; ++i) a.in[i] = (const float*)d_in[i];
    a.out = (float*)d_out; a.ws = (unsigned char*)d_ws;
    void* args[] = {&a};
    hipError_t e = hipLaunchCooperativeKernel((void*)mega, dim3(grid_blocks), dim3(NT), args, LDS_BYTES, stream);
    if (e != hipSuccess) fprintf(stderr, "cooperative launch failed: %s (grid %d)\n", hipGetErrorString(e), grid_blocks);
}
```

```cpp
#include <hip/hip_runtime.h>
#include <hip/hip_cooperative_groups.h>
#include <cstdio>
#include <cstdint>
namespace cg = cooperative_groups;
namespace pg8 {
#define PG8_LAS __attribute__((address_space(3)))
typedef unsigned short bf16_t;
typedef short bf16x8 __attribute__((ext_vector_type(8)));
typedef float f32x4 __attribute__((ext_vector_type(4)));
typedef unsigned u32x4 __attribute__((ext_vector_type(4)));
constexpr int BM = 256, BK = 64, HALF = 128, HTB = HALF * BK * 2  , STAGE_BYTES = 8 * HTB, NXCD = 8, WGM = 8;

__host__ __device__ __forceinline__ int lds_byte(int r, int c) { const int st = (r >> 4) * 2 + (c >> 5), rr = r & 15, cc = c & 31, ob = rr * 64 + cc * 2; return st * 1024 + (ob ^ (((ob >> 9) & 1) << 5)); }
__host__ __device__ __forceinline__ void stage_rc(int b, int& R, int& C) { const int st = b / 1024, sb = b % 1024, swz = sb ^ (((sb >> 9) & 1) << 5); R = (st >> 1) * 16 + swz / 64; C = (st & 1) * 32 + (swz % 64) / 2; }
__host__ __device__ __forceinline__ int perm32(int rho) { const int n = rho >> 4, i = rho & 15; return 8 * (i >> 2) + 4 * n + (i & 3); }

struct Unit { int pm, pn; };
struct Gemm { const bf16_t* A; const bf16_t* Bt; int M, N, K, lda; };

struct StaticOrder {
    int nM, nN, nwg, G, c;
    __host__ __device__ void init(int M, int N, int G_, int c_) { nM = M / BM; nN = N / BM; nwg = nM * nN; G = G_; c = c_; }
    __host__ __device__ bool next(int i, Unit& u) const {
        const long L = (long)i * G + c; if (L >= nwg) return false;
        int wgid = (int)L; { const int q = nwg / NXCD, r = nwg % NXCD, xcd = wgid % NXCD, off = wgid / NXCD; wgid = (xcd < r ? xcd * (q + 1) : r * (q + 1) + (xcd - r) * q) + off; }
        const int nig = WGM * nN, gid = wgid / nig, fm = gid * WGM, gsz = (nM - fm) < WGM ? (nM - fm) : WGM;
        u.pm = fm + ((wgid % nig) % gsz); u.pn = (wgid % nig) / gsz; return true;
    }
    __device__ __forceinline__ void a_ready(const Unit&) const {}
    __device__ __forceinline__ void done(const Unit&) const {}
};

__device__ __forceinline__ unsigned pk2(float lo, float hi) { typedef float f2_t __attribute__((ext_vector_type(2))); typedef __bf16 b2_t __attribute__((ext_vector_type(2))); f2_t v = {lo, hi}; b2_t b = __builtin_convertvector(v, b2_t); return __builtin_bit_cast(unsigned, b); }
__device__ __forceinline__ float bflo(unsigned w) { return __uint_as_float(w << 16); }
__device__ __forceinline__ float bfhi(unsigned w) { return __uint_as_float(w & 0xffff0000u); }
__device__ __forceinline__ u32x4 pack8(const f32x4 v0, const f32x4 v1) { u32x4 w; w.x = pk2(v0[0], v0[1]); w.y = pk2(v0[2], v0[3]); w.z = pk2(v1[0], v1[1]); w.w = pk2(v1[2], v1[3]); return w; }
__device__ __forceinline__ float sigmoidf_(float v) { return __builtin_amdgcn_rcpf(1.0f + __expf(-v)); }

constexpr int PW = 5888;
constexpr size_t MROWS = 32768;
struct EpiProj {
    static constexpr bool PERM = true, AFTER_DRAIN = false;
    bf16_t* O; const float* bg; const float* tabA; const float* tabR;
    template <int TYPE, int cs, int ws> __device__ __forceinline__ void half(const f32x4 (&acc)[2][2][4][2], int bj, int row0, int col0) const {
        f32x4 b0 = (f32x4){0.f, 0.f, 0.f, 0.f}, b1 = b0;
        if (TYPE == 6) { b0 = *(const f32x4*)(bg + col0 - 3840); b1 = *(const f32x4*)(bg + col0 - 3840 + 4); }
        char* const sbase = (char*)(O + MROWS * cs); const unsigned boff0 = ((unsigned)row0 * (unsigned)ws + (unsigned)(col0 - cs)) * 2u;
        const bool ropeA = (TYPE <= 1) && ((col0 & 63) < 16);
        const int gA = (col0 & 63) >> 3, gR = (col0 & 127) >> 3;
#pragma unroll
        for (int ai = 0; ai < 2; ++ai)
#pragma unroll
            for (int m = 0; m < 4; ++m) {
                const int row = row0 + ai * HALF + m * 16, pos = row & 4095;
                f32x4 v0 = acc[ai][bj][m][0], v1 = acc[ai][bj][m][1];
                if (TYPE == 0 || TYPE == 1) {
                    if (ropeA) {
                        const f32x4* t = (const f32x4*)(tabA + ((size_t)pos * 8 + gA * 4) * 2); const f32x4 t0 = t[0], t1 = t[1];
                        const f32x4 cv = (f32x4){t0[0], t0[2], t1[0], t1[2]}, sn = (f32x4){t0[1], t0[3], t1[1], t1[3]};
                        const f32x4 a = v0 * cv - v1 * sn, bb = v1 * cv + v0 * sn; v0 = a; v1 = bb;
                    }
                    if (TYPE == 0) { v0 = v0 * 0.125f; v1 = v1 * 0.125f; }
                } else if (TYPE == 3 || TYPE == 4) {
                    const f32x4* t = (const f32x4*)(tabR + ((size_t)pos * 64 + gR * 4) * 2); const f32x4 t0 = t[0], t1 = t[1];
                    const f32x4 cv = (f32x4){t0[0], t0[2], t1[0], t1[2]}, sn = (f32x4){t0[1], t0[3], t1[1], t1[3]};
                    const f32x4 a = v0 * cv - v1 * sn, bb = v1 * cv + v0 * sn; v0 = a; v1 = bb;
                    if (TYPE == 4) { v0 = v0 * 0.08838834764831845f; v1 = v1 * 0.08838834764831845f; }
                } else if (TYPE == 5) {
#pragma unroll
                    for (int e = 0; e < 4; ++e) { v0[e] = v0[e] * sigmoidf_(v0[e]); v1[e] = v1[e] * sigmoidf_(v1[e]); }
                } else if (TYPE == 6) {
#pragma unroll
                    for (int e = 0; e < 4; ++e) { v0[e] = sigmoidf_(v0[e] + b0[e]); v1[e] = sigmoidf_(v1[e] + b1[e]); }
                }
                *(u32x4*)(sbase + (boff0 + (unsigned)((ai * HALF + m * 16) * ws * 2))) = pack8(v0, v1);
            }
    }
    __device__ __forceinline__ void operator()(const f32x4 (&acc)[2][2][4][2], const Unit& u, int wr, int wc, int fr, int fq) const {
        const int row0 = u.pm * BM + wr * 64 + fr;
#pragma unroll
        for (int bj = 0; bj < 2; ++bj) {
            const int colbase = u.pn * BM + bj * HALF, sec = colbase >> 7, col0 = colbase + wc * 32 + 8 * fq;
            if (sec < 4) half<0, 0, 512>(acc, bj, row0, col0);
            else if (sec == 4) half<1, 512, 128>(acc, bj, row0, col0);
            else if (sec == 5) half<2, 640, 128>(acc, bj, row0, col0);
            else if (sec < 10) half<3, 768, 512>(acc, bj, row0, col0);
            else if (sec < 14) half<4, 1280, 512>(acc, bj, row0, col0);
            else if (sec < 22) half<2, 1792, 1024>(acc, bj, row0, col0);
            else if (sec < 30) half<5, 2816, 1024>(acc, bj, row0, col0);
            else if (sec < 38) half<6, 3840, 1024>(acc, bj, row0, col0);
            else half<6, 4864, 1024>(acc, bj, row0, col0);
        }
    }
};
#define EPI_CV(V_) (f32x4){bflo((V_).x), bfhi((V_).x), bflo((V_).y), bfhi((V_).y)}, (f32x4){bflo((V_).z), bfhi((V_).z), bflo((V_).w), bfhi((V_).w)}
struct EpiGateA {
    static constexpr bool PERM = true, AFTER_DRAIN = false;
    bf16_t* P;
    __device__ __forceinline__ void operator()(const f32x4 (&acc)[2][2][4][2], const Unit& u, int wr, int wc, int fr, int fq) const {
        const int row0 = u.pm * BM + wr * 64 + fr, colw = u.pn * BM + wc * 32 + 8 * fq;
        bf16_t* const base = P + MROWS * 3840 + (size_t)row0 * 1024 + colw;
#pragma unroll
        for (int ai = 0; ai < 2; ++ai)
#pragma unroll
            for (int mp = 0; mp < 2; ++mp) {
                u32x4 g[2][2];
#pragma unroll
                for (int mm = 0; mm < 2; ++mm)
#pragma unroll
                    for (int bj = 0; bj < 2; ++bj) g[mm][bj] = *(const u32x4*)(base + (size_t)(ai * HALF + (2 * mp + mm) * 16) * 1024 + bj * HALF);
#pragma unroll
                for (int mm = 0; mm < 2; ++mm)
#pragma unroll
                    for (int bj = 0; bj < 2; ++bj) { const int m = 2 * mp + mm; const f32x4 gg[2] = {EPI_CV(g[mm][bj])};
                        *(u32x4*)(base + (size_t)(ai * HALF + m * 16) * 1024 + bj * HALF) = pack8(acc[ai][bj][m][0] * gg[0], acc[ai][bj][m][1] * gg[1]); }
            }
    }
};
struct EpiMerge {
    static constexpr bool PERM = true, AFTER_DRAIN = false;
    bf16_t* P;
    __device__ __forceinline__ void operator()(const f32x4 (&acc)[2][2][4][2], const Unit& u, int wr, int wc, int fr, int fq) const {
        const int row0 = u.pm * BM + wr * 64 + fr, colw = u.pn * BM + wc * 32 + 8 * fq;
        const bf16_t* const tb = P + MROWS * 3840 + (size_t)row0 * 1024 + colw; bf16_t* const gb = P + MROWS * 4864 + (size_t)row0 * 1024 + colw;
#pragma unroll
        for (int ai = 0; ai < 2; ++ai)
#pragma unroll
            for (int mp = 0; mp < 2; ++mp) {
                u32x4 t[2][2], g[2][2];
#pragma unroll
                for (int mm = 0; mm < 2; ++mm)
#pragma unroll
                    for (int bj = 0; bj < 2; ++bj) { const size_t o = (size_t)(ai * HALF + (2 * mp + mm) * 16) * 1024 + bj * HALF; t[mm][bj] = *(const u32x4*)(tb + o); g[mm][bj] = *(const u32x4*)(gb + o); }
#pragma unroll
                for (int mm = 0; mm < 2; ++mm)
#pragma unroll
                    for (int bj = 0; bj < 2; ++bj) { const int m = 2 * mp + mm; const size_t o = (size_t)(ai * HALF + m * 16) * 1024 + bj * HALF;
                        const f32x4 gg[2] = {EPI_CV(g[mm][bj])}, tt[2] = {EPI_CV(t[mm][bj])};
                        *(u32x4*)(gb + o) = pack8(tt[0] + acc[ai][bj][m][0] * gg[0], tt[1] + acc[ai][bj][m][1] * gg[1]); }
            }
    }
};
struct EpiOut {
    static constexpr bool PERM = true, AFTER_DRAIN = false;
    const float* x; float* h1; bf16_t* xn2; const float* gain; float* ss;
    __device__ __forceinline__ void operator()(const f32x4 (&acc)[2][2][4][2], const Unit& u, int wr, int wc, int fr, int fq) const {
        const int row0 = u.pm * BM + wr * 64 + fr, colw = u.pn * BM + wc * 32 + 8 * fq;
        f32x4 gn[2][2];
#pragma unroll
        for (int bj = 0; bj < 2; ++bj) { gn[bj][0] = *(const f32x4*)(gain + colw + bj * HALF); gn[bj][1] = *(const f32x4*)(gain + colw + bj * HALF + 4); }
#pragma unroll
        for (int ai = 0; ai < 2; ++ai)
#pragma unroll
            for (int mp = 0; mp < 2; ++mp) {
                f32x4 xv[2][2][2];
#pragma unroll
                for (int mm = 0; mm < 2; ++mm)
#pragma unroll
                    for (int bj = 0; bj < 2; ++bj) { const size_t off = (size_t)(row0 + ai * HALF + (2 * mp + mm) * 16) * 1024 + colw + bj * HALF; xv[mm][bj][0] = *(const f32x4*)(x + off); xv[mm][bj][1] = *(const f32x4*)(x + off + 4); }
#pragma unroll
                for (int mm = 0; mm < 2; ++mm) {
                    const int m = 2 * mp + mm, row = row0 + ai * HALF + m * 16; float sq = 0.f;
#pragma unroll
                    for (int bj = 0; bj < 2; ++bj) { const size_t off = (size_t)row * 1024 + colw + bj * HALF;
                        const f32x4 ha = xv[mm][bj][0] + acc[ai][bj][m][0], hb = xv[mm][bj][1] + acc[ai][bj][m][1];
                        *(f32x4*)(h1 + off) = ha; *(f32x4*)(h1 + off + 4) = hb;
                        sq += (ha[0] * ha[0] + ha[1] * ha[1]) + (ha[2] * ha[2] + ha[3] * ha[3]) + (hb[0] * hb[0] + hb[1] * hb[1]) + (hb[2] * hb[2] + hb[3] * hb[3]);
                        *(u32x4*)(xn2 + off) = pack8(ha * gn[bj][0], hb * gn[bj][1]); }
                    asm volatile("s_nop 4" : "+v"(sq)); sq += __shfl_xor(sq, 16); asm volatile("s_nop 4" : "+v"(sq)); sq += __shfl_xor(sq, 32);
                    if (fq == 0) atomicAdd(ss + row, sq);
                }
            }
    }
};
struct EpiFF1 {
    static constexpr bool PERM = true, AFTER_DRAIN = false;
    bf16_t* hid; const float* ss;
    __device__ __forceinline__ void operator()(const f32x4 (&acc)[2][2][4][2], const Unit& u, int wr, int wc, int fr, int fq) const {
        const int row0 = u.pm * BM + wr * 64 + fr;
#pragma unroll
        for (int ai = 0; ai < 2; ++ai)
#pragma unroll
            for (int m = 0; m < 4; ++m) {
                const int row = row0 + ai * HALF + m * 16; const float r = rsqrtf(ss[row] * (1.0f / 1024.0f) + 1e-6f);
#pragma unroll
                for (int bj = 0; bj < 2; ++bj) {
                    const int col0 = u.pn * BM + bj * HALF + wc * 32 + 8 * fq;
                    f32x4 v0 = acc[ai][bj][m][0] * r, v1 = acc[ai][bj][m][1] * r;
#pragma unroll
                    for (int e = 0; e < 4; ++e) { const float a = fmaxf(v0[e], 0.f), b = fmaxf(v1[e], 0.f); v0[e] = a * a; v1[e] = b * b; }
                    *(u32x4*)(hid + (size_t)row * 4096 + col0) = pack8(v0, v1);
                }
            }
    }
};
struct EpiFF2 {
    static constexpr bool PERM = true, AFTER_DRAIN = false;
    float* h; float* ss;
    __device__ __forceinline__ void operator()(const f32x4 (&acc)[2][2][4][2], const Unit& u, int wr, int wc, int fr, int fq) const {
        const int row0 = u.pm * BM + wr * 64 + fr, colw = u.pn * BM + wc * 32 + 8 * fq;
#pragma unroll
        for (int ai = 0; ai < 2; ++ai)
#pragma unroll
            for (int mp = 0; mp < 2; ++mp) {
                f32x4 hv[2][2][2];
#pragma unroll
                for (int mm = 0; mm < 2; ++mm)
#pragma unroll
                    for (int bj = 0; bj < 2; ++bj) { const size_t off = (size_t)(row0 + ai * HALF + (2 * mp + mm) * 16) * 1024 + colw + bj * HALF; hv[mm][bj][0] = *(const f32x4*)(h + off); hv[mm][bj][1] = *(const f32x4*)(h + off + 4); }
#pragma unroll
                for (int mm = 0; mm < 2; ++mm) {
                    const int m = 2 * mp + mm, row = row0 + ai * HALF + m * 16; float sq = 0.f;
#pragma unroll
                    for (int bj = 0; bj < 2; ++bj) { const size_t off = (size_t)row * 1024 + colw + bj * HALF;
                        const f32x4 ha = hv[mm][bj][0] + acc[ai][bj][m][0], hb = hv[mm][bj][1] + acc[ai][bj][m][1];
                        *(f32x4*)(h + off) = ha; *(f32x4*)(h + off + 4) = hb;
                        sq += (ha[0] * ha[0] + ha[1] * ha[1]) + (ha[2] * ha[2] + ha[3] * ha[3]) + (hb[0] * hb[0] + hb[1] * hb[1]) + (hb[2] * hb[2] + hb[3] * hb[3]); }
                    asm volatile("s_nop 4" : "+v"(sq)); sq += __shfl_xor(sq, 16); asm volatile("s_nop 4" : "+v"(sq)); sq += __shfl_xor(sq, 32);
                    if (fq == 0) atomicAdd(ss + row, sq);
                }
            }
    }
};

template <class Epi, class Sched, bool ALIGN_EPI, bool SP2, int KC, int LDAC>
__device__ __forceinline__ void gemm_phase(PG8_LAS unsigned char* lds, const Gemm g, const Sched& S, const Epi& E) {
    int tid_ = threadIdx.x; asm volatile("" : "+v"(tid_)); const int tid = tid_, wid = __builtin_amdgcn_readfirstlane(tid >> 6), lane = tid & 63, wr = wid >> 2, wc = wid & 3, fr = lane & 15, fq = lane >> 4;
    constexpr int K = KC, nt = KC / BK, lda = LDAC;
    unsigned voffA[2], voffB[2];
#pragma unroll
    for (int i = 0; i < 2; ++i) { int R, C; stage_rc(tid * 16 + i * 8192, R, C); const int Rb = Epi::PERM ? ((R & ~31) + perm32(R & 31)) : R;
        voffA[i] = (unsigned)(R * lda + C) * 2u; voffB[i] = (unsigned)(Rb * K + C) * 2u; }
    const size_t kstep = (size_t)(BK * 2);
    const size_t hstepA = (size_t)HALF * lda * 2, hstepB = (size_t)HALF * K * 2;
    const size_t tstepA = 2 * hstepA, tstepB = 2 * hstepB;
    const unsigned ldsw = (unsigned)wid * 1024u;
    const int aoff = lds_byte(wr * 64 + fr, fq * 8), boff = lds_byte(wc * 32 + fr, fq * 8);
#define PG8_SA(b, h) (((b) * 2 + (h)) * HTB)
#define PG8_SB(b, h) ((4 + (b) * 2 + (h)) * HTB)
#define PG8_STAGE(bufoff, gbase, voff) do { _Pragma("unroll") for (int _i = 0; _i < 2; ++_i) \
        __builtin_amdgcn_global_load_lds((const unsigned*)((const char*)(gbase) + (voff)[_i]), (PG8_LAS unsigned*)(lds + (bufoff) + ldsw + _i * 8192), 16, 0, 0); } while (0)
#define PG8_LDA(dst, b, h) do { _Pragma("unroll") for (int m = 0; m < 4; ++m) _Pragma("unroll") for (int k = 0; k < 2; ++k) dst[m][k] = *(const PG8_LAS bf16x8*)(lds + PG8_SA(b, h) + aoff + m * 2048 + k * 1024); } while (0)
#define PG8_LDB(dst, b, h) do { _Pragma("unroll") for (int n = 0; n < 2; ++n) _Pragma("unroll") for (int k = 0; k < 2; ++k) dst[n][k] = *(const PG8_LAS bf16x8*)(lds + PG8_SB(b, h) + boff + n * 2048 + k * 1024); } while (0)
#define PG8_MMA(ai, bj, At, Bt) do { __builtin_amdgcn_s_setprio(1); _Pragma("unroll") for (int m = 0; m < 4; ++m) _Pragma("unroll") for (int n = 0; n < 2; ++n) _Pragma("unroll") for (int k = 0; k < 2; ++k) \
        acc[ai][bj][m][n] = __builtin_amdgcn_mfma_f32_16x16x32_bf16(Bt[n][k], At[m][k], acc[ai][bj][m][n], 0, 0, 0); __builtin_amdgcn_s_setprio(0); } while (0)
#define PG8_WAIT_V(n) asm volatile("s_waitcnt vmcnt(" #n ")" ::: "memory")
#define PG8_WAIT_L(n) asm volatile("s_waitcnt lgkmcnt(" #n ")" ::: "memory")
#define PG8_BAR __builtin_amdgcn_s_barrier()
#define PG8_SCHED __builtin_amdgcn_sched_barrier(0)
    Unit cur, nxt; int ui = 0;
    if (!S.next(0, cur)) return;
    f32x4 acc[2][2][4][2];
#pragma unroll
    for (int a = 0; a < 2; ++a)
#pragma unroll
        for (int b = 0; b < 2; ++b)
#pragma unroll
            for (int m = 0; m < 4; ++m)
#pragma unroll
                for (int n = 0; n < 2; ++n) acc[a][b][m][n] = (f32x4){0.f, 0.f, 0.f, 0.f};
    bf16x8 At[4][2], B0[2][2], B1[2][2];
    const char* cA = (const char*)g.A + (size_t)cur.pm * tstepA; const char* cB = (const char*)g.Bt + (size_t)cur.pn * tstepB;
    S.a_ready(cur);
    if constexpr (SP2) {
        PG8_STAGE(PG8_SB(0, 0), cB, voffB); PG8_STAGE(PG8_SB(0, 1), cB + hstepB, voffB); PG8_STAGE(PG8_SA(0, 0), cA, voffA); PG8_STAGE(PG8_SA(0, 1), cA + hstepA, voffA);
        if (wr == 1) PG8_BAR;
        PG8_WAIT_V(2); PG8_BAR;
        PG8_STAGE(PG8_SB(1, 0), cB + kstep, voffB); PG8_STAGE(PG8_SA(1, 0), cA + kstep, voffA); PG8_STAGE(PG8_SB(1, 1), cB + hstepB + kstep, voffB);
        PG8_WAIT_V(6); PG8_BAR;
    } else {
        PG8_STAGE(PG8_SB(0, 0), cB, voffB); PG8_STAGE(PG8_SA(0, 0), cA, voffA); PG8_STAGE(PG8_SB(0, 1), cB + hstepB, voffB); PG8_STAGE(PG8_SA(0, 1), cA + hstepA, voffA);
        if (wr == 1) PG8_BAR;
        PG8_WAIT_V(4); PG8_BAR;
        PG8_STAGE(PG8_SB(1, 0), cB + kstep, voffB); PG8_STAGE(PG8_SA(1, 0), cA + kstep, voffA); PG8_STAGE(PG8_SB(1, 1), cB + hstepB + kstep, voffB);
        PG8_WAIT_V(6); PG8_BAR;
    }
    for (;;) {
        const bool has_next = S.next(ui + 1, nxt);
        const char* nA = has_next ? (const char*)g.A + (size_t)nxt.pm * tstepA : cA; const char* nB = has_next ? (const char*)g.Bt + (size_t)nxt.pn * tstepB : cB;
        for (int t = 0; t < nt; t += 2) {
            const bool last = (t == nt - 2);
            const char* a1 = cA + (size_t)(t + 1) * kstep;
            const char* a2 = last ? nA : cA + (size_t)(t + 2) * kstep; const char* b2 = last ? nB : cB + (size_t)(t + 2) * kstep;
            const char* a3 = a2 + kstep; const char* b3 = b2 + kstep;
            if (last && has_next) S.a_ready(nxt);
            if constexpr (SP2) {
            PG8_LDB(B0, 0, 0); PG8_LDB(B1, 0, 1); PG8_SCHED; PG8_LDA(At, 0, 0); PG8_STAGE(PG8_SA(1, 1), a1 + hstepA, voffA);
            PG8_WAIT_V(8); PG8_WAIT_L(0); PG8_BAR; PG8_MMA(0, 0, At, B0); PG8_MMA(0, 1, At, B1); PG8_BAR; PG8_SCHED;
            PG8_LDA(At, 0, 1); PG8_STAGE(PG8_SB(0, 0), b2, voffB); PG8_STAGE(PG8_SB(0, 1), b2 + hstepB, voffB); PG8_STAGE(PG8_SA(0, 0), a2, voffA);
            PG8_WAIT_V(8); PG8_WAIT_L(0); PG8_BAR; PG8_MMA(1, 0, At, B0); PG8_MMA(1, 1, At, B1); PG8_BAR; PG8_SCHED;
            PG8_LDB(B0, 1, 0); PG8_LDB(B1, 1, 1); PG8_SCHED; PG8_LDA(At, 1, 0); PG8_STAGE(PG8_SA(0, 1), a2 + hstepA, voffA);
            PG8_WAIT_V(8); PG8_WAIT_L(0); PG8_BAR; PG8_MMA(0, 0, At, B0); PG8_MMA(0, 1, At, B1); PG8_BAR; PG8_SCHED;
            PG8_LDA(At, 1, 1); PG8_STAGE(PG8_SB(1, 0), b3, voffB); PG8_STAGE(PG8_SB(1, 1), b3 + hstepB, voffB); PG8_STAGE(PG8_SA(1, 0), a3, voffA);
            PG8_WAIT_V(8); PG8_WAIT_L(0); PG8_BAR; PG8_MMA(1, 0, At, B0); PG8_MMA(1, 1, At, B1); PG8_BAR; PG8_SCHED;
            } else {
            PG8_LDB(B0, 0, 0); PG8_SCHED; PG8_LDA(At, 0, 0); PG8_STAGE(PG8_SA(1, 1), a1 + hstepA, voffA);
            PG8_WAIT_L(8); PG8_BAR; PG8_WAIT_L(0); PG8_MMA(0, 0, At, B0); PG8_BAR; PG8_SCHED;
            PG8_LDB(B1, 0, 1); PG8_STAGE(PG8_SB(0, 0), b2, voffB);
            PG8_BAR; PG8_WAIT_L(0); PG8_MMA(0, 1, At, B1); PG8_BAR;
            PG8_LDA(At, 0, 1); PG8_STAGE(PG8_SA(0, 0), a2, voffA);
            PG8_BAR; PG8_WAIT_L(0); PG8_MMA(1, 0, At, B0); PG8_BAR; PG8_SCHED;
            PG8_STAGE(PG8_SB(0, 1), b2 + hstepB, voffB);
            PG8_WAIT_V(6); PG8_BAR; PG8_MMA(1, 1, At, B1); PG8_BAR;
            PG8_LDB(B0, 1, 0); PG8_SCHED; PG8_LDA(At, 1, 0); PG8_STAGE(PG8_SA(0, 1), a2 + hstepA, voffA);
            PG8_WAIT_L(8); PG8_BAR; PG8_WAIT_L(0); PG8_MMA(0, 0, At, B0); PG8_BAR; PG8_SCHED;
            PG8_LDB(B1, 1, 1); PG8_STAGE(PG8_SB(1, 0), b3, voffB);
            PG8_BAR; PG8_WAIT_L(0); PG8_MMA(0, 1, At, B1); PG8_BAR;
            PG8_LDA(At, 1, 1); PG8_STAGE(PG8_SA(1, 0), a3, voffA);
            PG8_BAR; PG8_WAIT_L(0); PG8_MMA(1, 0, At, B0); PG8_BAR; PG8_SCHED;
            PG8_STAGE(PG8_SB(1, 1), b3 + hstepB, voffB);
            PG8_WAIT_V(6); PG8_BAR; PG8_MMA(1, 1, At, B1); PG8_BAR;
            }
        }
        if constexpr (ALIGN_EPI) { if (wr == 0) PG8_BAR; }
        if constexpr (!Epi::AFTER_DRAIN) { E(acc, cur, wr, wc, fr, fq); S.done(cur); }
        if (!has_next) break;
#pragma unroll
        for (int a = 0; a < 2; ++a)
#pragma unroll
            for (int b = 0; b < 2; ++b)
#pragma unroll
                for (int m = 0; m < 4; ++m)
#pragma unroll
                    for (int n = 0; n < 2; ++n) acc[a][b][m][n] = (f32x4){0.f, 0.f, 0.f, 0.f};
        cur = nxt; cA = nA; cB = nB; ++ui;
        if constexpr (ALIGN_EPI) { if (wr == 1) PG8_BAR; }
    }
    PG8_WAIT_V(0);
    if constexpr (!ALIGN_EPI) { if (wr == 0) PG8_BAR; }
    PG8_BAR;
    if constexpr (Epi::AFTER_DRAIN) { E.fused(acc, cur, wr, wc, fr, fq, lds, wid, lane); S.done(cur); }
#undef PG8_SA
#undef PG8_SB
#undef PG8_STAGE
#undef PG8_LDA
#undef PG8_LDB
#undef PG8_MMA
#undef PG8_WAIT_V
#undef PG8_WAIT_L
#undef PG8_BAR
#undef PG8_SCHED
}
}

#define LAS __attribute__((address_space(3)))
typedef unsigned short bf16_t;
typedef unsigned u32x4 __attribute__((ext_vector_type(4)));
typedef unsigned u32x2 __attribute__((ext_vector_type(2)));
typedef float f32x4 __attribute__((ext_vector_type(4)));
typedef float f32x16 __attribute__((ext_vector_type(16)));
typedef short bf16x8 __attribute__((ext_vector_type(8)));
typedef short s16x4 __attribute__((ext_vector_type(4)));
using pg8::pk2;

constexpr int NT = 512;
constexpr int LDS_BYTES = 147456;
constexpr int M = 32768, D = 1024, SEQ = 4096, PW = 5888, FF = 4096;
constexpr size_t MiB = 1u << 20;
constexpr size_t SEC_QA = 0, SEC_KA = (size_t)M * 512, SEC_VA = (size_t)M * 640, SEC_QR = (size_t)M * 768, SEC_KR = (size_t)M * 1280, SEC_VR = (size_t)M * 1792, SEC_GR = (size_t)M * 2816, SEC_GB = (size_t)M * 4864;
constexpr size_t WS_WIN = 0, WS_WATT = 12 * MiB, WS_WRET = 13 * MiB, WS_WOUT = 15 * MiB, WS_W1 = 17 * MiB, WS_W2 = 25 * MiB;
constexpr size_t WS_TABA = 33 * MiB, WS_TABR = 34 * MiB, WS_SS1 = 36 * MiB, WS_SS2 = 36 * MiB + 512 * 1024;
constexpr size_t WS_CTL = 37 * MiB, CTL_BYTES = 16384;
constexpr int LDS_ST_OFF = LDS_BYTES - 16;
constexpr size_t WS_SX = 38 * MiB;
constexpr size_t WS_XN = 40 * MiB;
constexpr size_t WS_PROJ = 104 * MiB;
constexpr size_t WS_END = 472 * MiB;

struct Args { const float* in[13]; float* out; unsigned char* ws; };
#define XB_SYNC() xcd_barrier(xbar)

__device__ __forceinline__ float settle(float v) { asm volatile("s_nop 4" : "+v"(v)); return v; }
__device__ __forceinline__ float wave_sum(float v) {
#pragma unroll
    for (int o = 1; o < 64; o <<= 1) { v = settle(v); v += __shfl_xor(v, o); }
    return v;
}
__device__ __forceinline__ float ex2(float v) { return __builtin_amdgcn_exp2f(v); }
template <int CTRL> __device__ __forceinline__ float dpp_f(float v) { return __builtin_bit_cast(float, __builtin_amdgcn_update_dpp(0, __builtin_bit_cast(int, v), CTRL, 0xF, 0xF, false)); }
__device__ __forceinline__ float rsum16(float v) { v = settle(v); v += dpp_f<0xB1>(v); v = settle(v); v += dpp_f<0x4E>(v); v = settle(v); v += dpp_f<0x124>(v); v = settle(v); v += dpp_f<0x128>(v); return settle(v); }
__device__ __forceinline__ int crow(int r, int hi) { return (r & 3) + 8 * (r >> 2) + 4 * hi; }


#define XB_TMO      128
#define XB_XCNT(j)  (256  + 64 * (j))
#define XB_XSUB(j)  (1280 + 64 * (j))
#define XB_XGEN(j)  (2304 + 64 * (j))
#define XB_TOP      3328
#define XB_TOPGEN   3392
#define XCD_BAR_WORDS 3456
#define XB_SPIN_CAP (1u << 18)
__device__ __forceinline__ unsigned xb_ld(unsigned* p)              { return __hip_atomic_load(p, __ATOMIC_RELAXED, __HIP_MEMORY_SCOPE_AGENT); }
__device__ __forceinline__ unsigned xb_add(unsigned* p, unsigned v) { return __hip_atomic_fetch_add(p, v, __ATOMIC_RELAXED, __HIP_MEMORY_SCOPE_AGENT); }
__device__ __forceinline__ unsigned xb_xcc_id() { return (unsigned)__builtin_amdgcn_s_getreg((3 << 11) | 20) & 0xFu; }
#define XB_SPIN(cond, bar) do { unsigned _sp = 0; while (cond) { __builtin_amdgcn_s_sleep(1); \
    if ((++_sp & 255u) == 0u) { if (xb_ld(&(bar)[XB_TMO])) break; if (_sp > XB_SPIN_CAP) { atomicAdd(&(bar)[XB_TMO], 1u); break; } } } } while (0)
struct XcdBarrier { unsigned* bar; unsigned x; volatile LAS unsigned* st; };
__device__ __forceinline__ XcdBarrier xcd_barrier_post(unsigned* bar, volatile LAS unsigned* st) {
    XcdBarrier b; b.bar = bar; b.x = xb_xcc_id(); b.st = st;
    if (threadIdx.x == 0) (void)xb_add(&bar[XB_XCNT(b.x)], 1u);
    return b;
}
__device__ __forceinline__ void xcd_barrier_complete(unsigned* bar, unsigned x, unsigned& nloc, unsigned& nx) {
    const unsigned G = gridDim.x * gridDim.y * gridDim.z;
    unsigned sum, cnt, mine, sp = 0u;
    for (;;) {
        sum = 0u; cnt = 0u; mine = 0u;
#pragma unroll
        for (unsigned j = 0; j < 16; ++j) { const unsigned c = xb_ld(&bar[XB_XCNT(j)]); sum += c; cnt += (c > 0u) ? 1u : 0u; mine = (j == x) ? c : mine; }
        if (sum == G) break;
        __builtin_amdgcn_s_sleep(1);
        if ((++sp & 255u) == 0u) { if (xb_ld(&bar[XB_TMO])) break; if (sp > XB_SPIN_CAP) { atomicAdd(&bar[XB_TMO], 1u); break; } }
    }
    nloc = mine > 0u ? mine : 1u; nx = cnt > 0u ? cnt : 1u;
}
__device__ __forceinline__ void xcd_barrier(const XcdBarrier& b) {
    asm volatile("s_waitcnt vmcnt(0)" ::: "memory");
    __syncthreads();
    if (threadIdx.x == 0) {
        unsigned* bar = b.bar;
        __builtin_amdgcn_s_waitcnt(0);
        unsigned nloc = b.st[0], nx = b.st[1];
        if (nloc == 0u) { xcd_barrier_complete(bar, b.x, nloc, nx); b.st[0] = nloc; b.st[1] = nx; }
        const unsigned old = xb_add(&bar[XB_XSUB(b.x)], 1u);
        const unsigned gen = old / nloc;
        if (old + 1u == (gen + 1u) * nloc) {
            __builtin_amdgcn_fence(__ATOMIC_RELEASE, "agent");
            asm volatile("s_waitcnt vmcnt(0)" ::: "memory");
            const unsigned og = xb_add(&bar[XB_TOP], 1u);
            const unsigned tg = og / nx;
            if (og + 1u == (tg + 1u) * nx) xb_add(&bar[XB_TOPGEN], 1u);
            else XB_SPIN(xb_ld(&bar[XB_TOPGEN]) == tg, bar);
            __builtin_amdgcn_fence(__ATOMIC_ACQUIRE, "");
            asm volatile("s_waitcnt vmcnt(0)" ::: "memory");
            xb_add(&bar[XB_XGEN(b.x)], 1u);
        } else {
            XB_SPIN(xb_ld(&bar[XB_XGEN(b.x)]) == gen, bar);
            __builtin_amdgcn_fence(__ATOMIC_ACQUIRE, "agent");
            asm volatile("s_waitcnt vmcnt(0)" ::: "memory");
        }
    }
    __syncthreads();
}

__device__ __forceinline__ int src_col(int n) {
    if (n < 640) { const int p = n & 63; if (p < 16) { const int g = p >> 3, w = p & 7; return (n & ~63) + ((w < 4) ? (4 * g + w) : (8 + 4 * g + (w - 4))); } return n; }
    if (n >= 768 && n < 1792) { const int p = n & 127, g = p >> 3, w = p & 7; return (n & ~127) + ((w < 4) ? (4 * g + w) : (64 + 4 * g + (w - 4))); }
    return n;
}
__device__ __forceinline__ void p0_transpose_item(const float* W, int K, int N, bf16_t* WT, LAS float* scr, int item, int lane, bool perm) {
    const int nblk = N / 32, kb = item / nblk, nb = item % nblk, k0 = 64 * kb, n0 = 32 * nb;
    const int ncol = perm ? src_col(n0 + (lane & 31)) : (n0 + (lane & 31));
#pragma unroll
    for (int i = 0; i < 32; ++i) { const int kk = 2 * i + (lane >> 5); scr[kk * 33 + (lane & 31)] = W[(size_t)(k0 + kk) * N + ncol]; }
    asm volatile("s_waitcnt lgkmcnt(0)" ::: "memory");
    const int c = lane & 7;
#pragma unroll
    for (int j = 0; j < 4; ++j) { const int n = (lane >> 3) + 8 * j; const LAS float* s = scr + (8 * c) * 33 + n;
        u32x4 o; o.x = pk2(s[0 * 33], s[1 * 33]); o.y = pk2(s[2 * 33], s[3 * 33]); o.z = pk2(s[4 * 33], s[5 * 33]); o.w = pk2(s[6 * 33], s[7 * 33]);
        *(u32x4*)(WT + (size_t)(n0 + n) * K + k0 + 8 * c) = o; }
    asm volatile("s_waitcnt lgkmcnt(0)" ::: "memory");
}
__device__ __forceinline__ void rope_entry(float theta, int dim, int pos, int i, float* out2) {
    const float e = -(float)(2 * i) / (float)dim;
    const float inv_freq = (float)exp((double)e * log((double)theta));
    const float ang = (float)pos * inv_freq;
    const double a = (double)ang;
    const double qd = rint(a * 0.63661977236758134308);
    const double r = a - qd * 1.57079632679489661923, r2 = r * r;
    const double sn = r * (1.0 - r2 / 6.0 * (1.0 - r2 / 20.0 * (1.0 - r2 / 42.0 * (1.0 - r2 / 72.0 * (1.0 - r2 / 110.0 * (1.0 - r2 / 156.0))))));
    const double cs = 1.0 - r2 / 2.0 * (1.0 - r2 / 12.0 * (1.0 - r2 / 30.0 * (1.0 - r2 / 56.0 * (1.0 - r2 / 90.0 * (1.0 - r2 / 132.0 * (1.0 - r2 / 182.0))))));
    const int qq = ((int)qd) & 3;
    double c2 = cs, s2 = sn;
    if (qq == 1) { c2 = -sn; s2 = cs; } else if (qq == 2) { c2 = -cs; s2 = -sn; } else if (qq == 3) { c2 = sn; s2 = -cs; }
    out2[0] = (float)c2; out2[1] = (float)s2;
}

__device__ __forceinline__ void attn_unit(LAS unsigned char* lds, bf16_t* P, const float* sinks, int unit, int tid) {
    asm volatile("" : "+v"(tid));
    const int lane = tid & 63, w = __builtin_amdgcn_readfirstlane(tid >> 6), r32 = lane & 31, h = lane >> 5;
    const int blk = unit & 31, kvh = (unit >> 5) & 1, b = unit >> 6;
    const long rowbase = (long)b * SEQ + blk * 128;
    LAS unsigned char* Ks = lds;
    LAS unsigned short* Vt = (LAS unsigned short*)(lds + 36864);
#pragma unroll
    for (int i = 0; i < 4; ++i) {
        const int idx = tid + i * 512, key = idx & 255, ch = idx >> 8;
        const bool valid = (blk > 0) || (key >= 128);
        u32x4 kv = (u32x4){0u, 0u, 0u, 0u}, vv = kv;
        if (valid) { const size_t r = (size_t)(rowbase - 128 + key); kv = *(const u32x4*)(P + SEC_KA + r * 128 + kvh * 64 + ch * 8); vv = *(const u32x4*)(P + SEC_VA + r * 128 + kvh * 64 + ch * 8); }
        *(LAS u32x4*)(Ks + key * 144 + ch * 16) = kv;
        LAS unsigned short* vd = Vt + (ch * 8) * 260 + key;
        vd[0 * 260] = (unsigned short)(vv.x & 0xffffu); vd[1 * 260] = (unsigned short)(vv.x >> 16);
        vd[2 * 260] = (unsigned short)(vv.y & 0xffffu); vd[3 * 260] = (unsigned short)(vv.y >> 16);
        vd[4 * 260] = (unsigned short)(vv.z & 0xffffu); vd[5 * 260] = (unsigned short)(vv.z >> 16);
        vd[6 * 260] = (unsigned short)(vv.w & 0xffffu); vd[7 * 260] = (unsigned short)(vv.w >> 16);
    }
    __syncthreads();
    const int head = kvh * 4 + (w >> 1);
    const float sink = sinks[head];
#pragma unroll 1
    for (int hf = 0; hf < 2; ++hf) {
        const int r0 = (w & 1) * 64 + hf * 32;
        const bf16_t* qptr = P + SEC_QA + (size_t)(rowbase + r0 + r32) * 512 + head * 64 + 8 * h;
        bf16x8 qf[4];
#pragma unroll
        for (int s = 0; s < 4; ++s) qf[s] = *(const bf16x8*)(qptr + 16 * s);
        f32x16 x[5];
#pragma unroll
        for (int kt = 0; kt < 5; ++kt) {
            f32x16 a0;
#pragma unroll
            for (int i = 0; i < 16; ++i) a0[i] = 0.f;
#pragma unroll
            for (int s = 0; s < 4; ++s) { const bf16x8 a = *(const LAS bf16x8*)(Ks + (r0 + kt * 32 + r32) * 144 + (16 * s + 8 * h) * 2); a0 = __builtin_amdgcn_mfma_f32_32x32x16_bf16(a, qf[s], a0, 0, 0, 0); }
            x[kt] = a0;
        }
        const int qi = r0 + r32;
        float mx = sink;
#pragma unroll
        for (int kt = 0; kt < 5; ++kt)
#pragma unroll
            for (int i = 0; i < 16; ++i) { const int f = r0 + kt * 32 + crow(i, h); const bool ok = (f > qi) && (f <= qi + 128) && ((blk > 0) || (f >= 128)); const float v = ok ? x[kt][i] : -1e30f; x[kt][i] = v; mx = fmaxf(mx, v); }
        mx = settle(mx); mx = fmaxf(mx, __shfl_xor(mx, 32));
        float l = 0.f;
#pragma unroll
        for (int kt = 0; kt < 5; ++kt)
#pragma unroll
            for (int i = 0; i < 16; ++i) { const float e = __expf(x[kt][i] - mx); x[kt][i] = e; l += e; }
        l = settle(l); l += __shfl_xor(l, 32); l += __expf(sink - mx);
        const float inv = 1.0f / l;
        f32x16 o[2];
#pragma unroll
        for (int i = 0; i < 16; ++i) { o[0][i] = 0.f; o[1][i] = 0.f; }
#pragma unroll
        for (int kt = 0; kt < 5; ++kt)
#pragma unroll
            for (int s2 = 0; s2 < 2; ++s2) {
                u32x4 pw; pw.x = pk2(x[kt][8 * s2 + 0] * inv, x[kt][8 * s2 + 1] * inv); pw.y = pk2(x[kt][8 * s2 + 2] * inv, x[kt][8 * s2 + 3] * inv);
                pw.z = pk2(x[kt][8 * s2 + 4] * inv, x[kt][8 * s2 + 5] * inv); pw.w = pk2(x[kt][8 * s2 + 6] * inv, x[kt][8 * s2 + 7] * inv);
                const bf16x8 pa = __builtin_bit_cast(bf16x8, pw);
#pragma unroll
                for (int dt = 0; dt < 2; ++dt) {
                    const LAS unsigned short* vb = Vt + (32 * dt + r32) * 260 + r0 + kt * 32 + 16 * s2 + 4 * h;
                    const s16x4 lo = *(const LAS s16x4*)vb, hi = *(const LAS s16x4*)(vb + 8);
                    const bf16x8 vf = __builtin_shufflevector(lo, hi, 0, 1, 2, 3, 4, 5, 6, 7);
                    o[dt] = __builtin_amdgcn_mfma_f32_32x32x16_bf16(pa, vf, o[dt], 0, 0, 0);
                }
            }
#pragma unroll
        for (int dt = 0; dt < 2; ++dt)
#pragma unroll
            for (int i = 0; i < 16; ++i) { const unsigned wv = pk2(o[dt][i], 0.f); P[SEC_QA + (size_t)(rowbase + r0 + crow(i, h)) * 512 + head * 64 + 32 * dt + r32] = (bf16_t)(wv & 0xffffu); }
    }
    __syncthreads();
}

__device__ __forceinline__ void scan_unit(LAS unsigned char* lds, const bf16_t* P, bf16_t* ST, int unit, int tid) {
    asm volatile("" : "+v"(tid));
    const int lane = tid & 63, w = __builtin_amdgcn_readfirstlane(tid >> 6), l15 = lane & 15, q = lane >> 4;
    const int sl = unit & 7, hh = (unit >> 3) & 3, b = unit >> 5;
    const float lg2 = log1pf(-exp2f(-5.0f - (float)hh)) * 1.4426950408889634f;
    const float cdec = ex2(128.0f * lg2);
    LAS unsigned short* Kt = (LAS unsigned short*)lds;
    LAS unsigned short* Vt = Kt + 128 * 128;
    f32x4 acc[2]; acc[0] = (f32x4){0.f, 0.f, 0.f, 0.f}; acc[1] = acc[0];
    const size_t row0 = (size_t)b * SEQ;
    const int kkey0 = tid >> 4, kch = tid & 15, vkey = tid >> 2, vch = tid & 3;
    const bf16_t* kbase = P + SEC_KR + (row0 + kkey0) * 512 + hh * 128 + kch * 8;
    const bf16_t* vbase = P + SEC_VR + (row0 + vkey) * 1024 + hh * 256 + sl * 32 + vch * 8;
    float dec[4];
#pragma unroll
    for (int i = 0; i < 4; ++i) dec[i] = ex2((float)(127 - (kkey0 + 32 * i)) * lg2);
    u32x4 kA[4], vA, kB[4], vB, kC[4], vC, kD[4], vD;
#pragma unroll
    for (int i = 0; i < 4; ++i) { kA[i] = *(const u32x4*)(kbase + (size_t)(32 * i) * 512); kB[i] = *(const u32x4*)(kbase + (size_t)(128 + 32 * i) * 512);
                                  kC[i] = *(const u32x4*)(kbase + (size_t)(256 + 32 * i) * 512); kD[i] = *(const u32x4*)(kbase + (size_t)(384 + 32 * i) * 512); }
    vA = *(const u32x4*)vbase; vB = *(const u32x4*)(vbase + (size_t)128 * 1024); vC = *(const u32x4*)(vbase + (size_t)256 * 1024); vD = *(const u32x4*)(vbase + (size_t)384 * 1024);
    int kpos[8], vpos[8];
#pragma unroll
    for (int e = 0; e < 8; ++e) { const int dk = 8 * kch + e, dv = 8 * vch + e;
        kpos[e] = dk * 128 + ((((kkey0 >> 3) ^ ((dk ^ kch) & 15)) & 15) << 3) + (kkey0 & 7);
        vpos[e] = dv * 128 + ((((vkey >> 3) ^ ((dv ^ vch) & 15)) & 15) << 3) + (vkey & 7); }
    const int rk = 16 * w + l15, gk = (rk ^ (rk >> 3)) & 15, gv0 = (l15 ^ (l15 >> 3)) & 15, gv1 = ((16 + l15) ^ ((16 + l15) >> 3)) & 15;
#define SCAN_STEP(c, KR, VR) do { \
        _Pragma("unroll") for (int tc = 0; tc < 2; ++tc) { u32x2 wv; wv.x = pk2(acc[tc][0], acc[tc][1]); wv.y = pk2(acc[tc][2], acc[tc][3]); \
            *(u32x2*)(ST + ((size_t)((b * 4 + hh) * 32 + (c)) * 256 + sl * 32 + tc * 16 + l15) * 128 + 16 * w + 4 * q) = wv; } \
        __syncthreads(); \
        _Pragma("unroll") for (int i = 0; i < 4; ++i) { const u32x4 kv = KR[i]; const float dc = dec[i]; unsigned t; \
              \
            t = pk2(pg8::bflo(kv.x) * dc, pg8::bfhi(kv.x) * dc); Kt[kpw(kpos[0], i)] = (unsigned short)(t & 0xffffu); Kt[kpw(kpos[1], i)] = (unsigned short)(t >> 16); \
            t = pk2(pg8::bflo(kv.y) * dc, pg8::bfhi(kv.y) * dc); Kt[kpw(kpos[2], i)] = (unsigned short)(t & 0xffffu); Kt[kpw(kpos[3], i)] = (unsigned short)(t >> 16); \
            t = pk2(pg8::bflo(kv.z) * dc, pg8::bfhi(kv.z) * dc); Kt[kpw(kpos[4], i)] = (unsigned short)(t & 0xffffu); Kt[kpw(kpos[5], i)] = (unsigned short)(t >> 16); \
            t = pk2(pg8::bflo(kv.w) * dc, pg8::bfhi(kv.w) * dc); Kt[kpw(kpos[6], i)] = (unsigned short)(t & 0xffffu); Kt[kpw(kpos[7], i)] = (unsigned short)(t >> 16); } \
        { Vt[vpos[0]] = (unsigned short)(VR.x & 0xffffu); Vt[vpos[1]] = (unsigned short)(VR.x >> 16); \
          Vt[vpos[2]] = (unsigned short)(VR.y & 0xffffu); Vt[vpos[3]] = (unsigned short)(VR.y >> 16); \
          Vt[vpos[4]] = (unsigned short)(VR.z & 0xffffu); Vt[vpos[5]] = (unsigned short)(VR.z >> 16); \
          Vt[vpos[6]] = (unsigned short)(VR.w & 0xffffu); Vt[vpos[7]] = (unsigned short)(VR.w >> 16); } \
        if ((c) + 4 < 32) { const size_t offr = (size_t)((c) + 4) * 128; \
            _Pragma("unroll") for (int i = 0; i < 4; ++i) KR[i] = *(const u32x4*)(kbase + (offr + 32 * i) * 512); \
            VR = *(const u32x4*)(vbase + offr * 1024); } \
        __syncthreads(); \
        acc[0] = acc[0] * cdec; acc[1] = acc[1] * cdec; \
        _Pragma("unroll") for (int s = 0; s < 4; ++s) { \
            const bf16x8 a = *(const LAS bf16x8*)(Kt + rk * 128 + (((4 * s + q) ^ gk) << 3)); \
            const bf16x8 b0 = *(const LAS bf16x8*)(Vt + l15 * 128 + (((4 * s + q) ^ gv0) << 3)); \
            const bf16x8 b1 = *(const LAS bf16x8*)(Vt + (16 + l15) * 128 + (((4 * s + q) ^ gv1) << 3)); \
            acc[0] = __builtin_amdgcn_mfma_f32_16x16x32_bf16(a, b0, acc[0], 0, 0, 0); acc[1] = __builtin_amdgcn_mfma_f32_16x16x32_bf16(a, b1, acc[1], 0, 0, 0); } \
    } while (0)
#define kpw(pos, i) ((pos) ^ ((4 * (i)) << 3))
#pragma unroll 1
    for (int c = 0; c < 32; c += 4) { SCAN_STEP(c, kA, vA); SCAN_STEP(c + 1, kB, vB); SCAN_STEP(c + 2, kC, vC); SCAN_STEP(c + 3, kD, vD); }
#undef SCAN_STEP
#undef kpw
    __syncthreads();
}

__device__ __forceinline__ void pos0_partial(LAS unsigned char* lds, const float* x, const float* gmix, const float* win, float* sx, int item, int tid) {
    const int part = item & 3, hh = (item >> 2) & 3, b = item >> 4;
    LAS float* xg = (LAS float*)(lds + 137216);
    LAS float* hp = xg + 256;
    if (tid < 256) { const int k = part * 256 + tid; xg[tid] = x[(size_t)b * SEQ * D + k] * gmix[k]; }
    __syncthreads();
    const int d2 = tid & 255, kh = tid >> 8;
    const float* wp = win + (size_t)(part * 256 + kh * 128) * PW + (d2 < 128 ? 768 + hh * 128 + d2 : 1280 + hh * 128 + (d2 - 128));
    float acc = 0.f;
#pragma unroll 32
    for (int k = 0; k < 128; ++k) acc += xg[kh * 128 + k] * wp[(size_t)k * PW];
    hp[kh * 256 + d2] = acc;
    __syncthreads();
    if (tid < 256) sx[(size_t)item * 256 + tid] = hp[tid] + hp[256 + tid];
    __syncthreads();
}

__device__ __forceinline__ void retout_unit(LAS unsigned char* lds, bf16_t* P, const bf16_t* ST, const float* gn, int unit, int tid, const float* x, const float* sx) {
    asm volatile("" : "+v"(tid));
    const int lane = tid & 63, w = __builtin_amdgcn_readfirstlane(tid >> 6), l15 = lane & 15, q = lane >> 4;
    const int c = unit & 31, hh = (unit >> 5) & 3, b = unit >> 7;
    const size_t rowc = (size_t)b * SEQ + c * 128;
    const float lg2 = log1pf(-exp2f(-5.0f - (float)hh)) * 1.4426950408889634f;
    float s_exact = 0.f;
    if (c == 0) {
        LAS float* red = (LAS float*)(lds + 137216);
        const float* xrow = x + rowc * D;
        float ssq = 0.f;
#pragma unroll
        for (int k = tid; k < 1024; k += 512) { const float xv = xrow[k]; ssq += xv * xv; }
        ssq = wave_sum(ssq); if (lane == 0) red[w] = ssq;
        if (tid < 128) { const float* sp = sx + (size_t)((b * 4 + hh) * 4) * 256 + tid;
                         const float qs = (sp[0] + sp[256]) + (sp[512] + sp[768]), ks = (sp[128] + sp[384]) + (sp[640] + sp[896]);
                         const float pr = wave_sum(qs * ks); if (lane == 0) red[8 + w] = pr; }
        __syncthreads();
        float tot = 0.f;
#pragma unroll
        for (int i = 0; i < 8; ++i) tot += red[i];
        const float rs = rsqrtf(tot * (1.0f / D) + 1e-6f);
        s_exact = (red[8] + red[9]) * rs * rs * 0.08838834764831845f;
    }
    LAS unsigned short* RA = (LAS unsigned short*)lds;
    LAS unsigned short* Ks = (LAS unsigned short*)(lds + 69632);
    const bf16_t* st = ST + (size_t)((b * 4 + hh) * 32 + c) * 32768;
    if (c != 0)
#pragma unroll
    for (int i = 0; i < 8; ++i) { const int idx = tid + i * 512, dv = idx >> 4, ch = idx & 15; *(LAS u32x4*)(RA + dv * 136 + ch * 8) = *(const u32x4*)(st + dv * 128 + ch * 8); }
#pragma unroll
    for (int i = 0; i < 4; ++i) { const int idx = tid + i * 512, key = idx >> 4, ch = idx & 15; *(LAS u32x4*)(Ks + key * 136 + ch * 8) = *(const u32x4*)(P + SEC_KR + (rowc + key) * 512 + hh * 128 + ch * 8); }
    u32x4 vreg[8];
#pragma unroll
    for (int i = 0; i < 8; ++i) { const int idx = tid + i * 512, key = idx & 127, ch = idx >> 7; vreg[i] = *(const u32x4*)(P + SEC_VR + (rowc + key) * 1024 + hh * 256 + ch * 8); }
    bf16x8 qf[4];
#pragma unroll
    for (int s = 0; s < 4; ++s) qf[s] = *(const bf16x8*)(P + SEC_QR + (rowc + 16 * w + l15) * 512 + hh * 128 + 32 * s + 8 * q);
    __syncthreads();
    f32x4 acc[16];
#pragma unroll
    for (int n = 0; n < 16; ++n) {
        f32x4 a0 = (f32x4){0.f, 0.f, 0.f, 0.f};
#pragma unroll
        for (int s = 0; s < (c == 0 ? 0 : 4); ++s) a0 = __builtin_amdgcn_mfma_f32_16x16x32_bf16(qf[s], *(const LAS bf16x8*)(RA + (16 * n + l15) * 136 + 32 * s + 8 * q), a0, 0, 0, 0);
        acc[n] = a0;
    }
    {
        f32x4 qd;
#pragma unroll
        for (int j = 0; j < 4; ++j) qd[j] = ex2((float)(16 * w + 4 * q + j + 1) * lg2);
#pragma unroll
        for (int n = 0; n < 16; ++n) acc[n] = acc[n] * qd;
    }
    f32x4 xt[8];
#pragma unroll
    for (int t = 0; t < 8; ++t) {
        f32x4 a0 = (f32x4){0.f, 0.f, 0.f, 0.f};
        if (t <= w) {
#pragma unroll
            for (int s = 0; s < 4; ++s) a0 = __builtin_amdgcn_mfma_f32_16x16x32_bf16(*(const LAS bf16x8*)(Ks + (16 * t + l15) * 136 + 32 * s + 8 * q), qf[s], a0, 0, 0, 0);
            if (t == 0 && c == 0 && w == 0 && lane == 0) a0[0] = s_exact;
#pragma unroll
            for (int j = 0; j < 4; ++j) { const int d = (16 * w + l15) - (16 * t + 4 * q + j); a0[j] = (d >= 0) ? a0[j] * ex2((float)d * lg2) : 0.f; }
        }
        xt[t] = a0;
    }
    __syncthreads();
#pragma unroll
    for (int i = 0; i < 8; ++i) { const int idx = tid + i * 512, key = idx & 127, ch = idx >> 7; LAS unsigned short* vd = RA + (ch * 8) * 132 + key; const u32x4 vv = vreg[i];
        vd[0 * 132] = (unsigned short)(vv.x & 0xffffu); vd[1 * 132] = (unsigned short)(vv.x >> 16);
        vd[2 * 132] = (unsigned short)(vv.y & 0xffffu); vd[3 * 132] = (unsigned short)(vv.y >> 16);
        vd[4 * 132] = (unsigned short)(vv.z & 0xffffu); vd[5 * 132] = (unsigned short)(vv.z >> 16);
        vd[6 * 132] = (unsigned short)(vv.w & 0xffffu); vd[7 * 132] = (unsigned short)(vv.w >> 16); }
    __syncthreads();
#pragma unroll
    for (int u = 0; u < 4; ++u) {
        if (2 * u <= w) {
            u32x4 pw; pw.x = pk2(xt[2 * u][0], xt[2 * u][1]); pw.y = pk2(xt[2 * u][2], xt[2 * u][3]); pw.z = pk2(xt[2 * u + 1][0], xt[2 * u + 1][1]); pw.w = pk2(xt[2 * u + 1][2], xt[2 * u + 1][3]);
            const bf16x8 pa = __builtin_bit_cast(bf16x8, pw);
#pragma unroll
            for (int n = 0; n < 16; ++n) {
                const LAS unsigned short* vb = RA + (16 * n + l15) * 132 + 32 * u + 4 * q;
                const s16x4 lo = *(const LAS s16x4*)vb, hi = *(const LAS s16x4*)(vb + 16);
                const bf16x8 vf = __builtin_shufflevector(lo, hi, 0, 1, 2, 3, 4, 5, 6, 7);
                acc[n] = __builtin_amdgcn_mfma_f32_16x16x32_bf16(pa, vf, acc[n], 0, 0, 0);
            }
        }
    }
    LAS unsigned short* Yw = (LAS unsigned short*)(lds + 69632) + w * (16 * 264);
    float gnv[16];
#pragma unroll
    for (int n = 0; n < 16; ++n) gnv[n] = gn[hh * 256 + 16 * n + l15];
#pragma unroll
    for (int j = 0; j < 4; ++j) {
        float s = 0.f;
#pragma unroll
        for (int n = 0; n < 16; ++n) s += acc[n][j];
        s = rsum16(s);
        const float mu = s * (1.0f / 256.0f);
        float v = 0.f;
#pragma unroll
        for (int n = 0; n < 16; ++n) { const float d = acc[n][j] - mu; v += d * d; }
        v = rsum16(v);
        const float rstd = rsqrtf(v * (1.0f / 256.0f) + 1e-6f);
#pragma unroll
        for (int n = 0; n < 16; ++n) { const float yn = (acc[n][j] - mu) * rstd * gnv[n]; Yw[(4 * q + j) * 264 + 16 * n + l15] = (unsigned short)(pk2(yn, 0.f) & 0xffffu); }
    }
    {
        u32x4 gq[8]; bf16_t* gp[8];
#pragma unroll
        for (int k = 0; k < 8; ++k) { const int id = lane + 64 * k, row = id >> 5, ch = id & 31; gp[k] = P + SEC_GR + (rowc + 16 * w + row) * 1024 + hh * 256 + ch * 8; gq[k] = *(const u32x4*)gp[k]; }
#pragma unroll
        for (int k = 0; k < 8; ++k) { const int id = lane + 64 * k, row = id >> 5, ch = id & 31;
            const u32x4 yv = *(const LAS u32x4*)(Yw + row * 264 + ch * 8); const u32x4 g = gq[k]; u32x4 o;
            o.x = pk2(pg8::bflo(yv.x) * pg8::bflo(g.x), pg8::bfhi(yv.x) * pg8::bfhi(g.x)); o.y = pk2(pg8::bflo(yv.y) * pg8::bflo(g.y), pg8::bfhi(yv.y) * pg8::bfhi(g.y));
            o.z = pk2(pg8::bflo(yv.z) * pg8::bflo(g.z), pg8::bfhi(yv.z) * pg8::bfhi(g.z)); o.w = pk2(pg8::bflo(yv.w) * pg8::bflo(g.w), pg8::bfhi(yv.w) * pg8::bfhi(g.w));
            *(u32x4*)gp[k] = o; }
    }
    __syncthreads();
}

__global__ void __launch_bounds__(NT, 2) mega(Args a) {
    extern __shared__ __attribute__((aligned(16))) unsigned char lds_raw[];
    LAS unsigned char* lds = (LAS unsigned char*)lds_raw;
    cg::grid_group grid = cg::this_grid();
    const int tid = threadIdx.x, lane = tid & 63, wave = __builtin_amdgcn_readfirstlane(tid >> 6);
    const int G = gridDim.x, bid = blockIdx.x;
    const int gw = bid * 8 + wave, NGW = G * 8;
    unsigned char* ws = a.ws;
    const float* x = a.in[0];
    bf16_t* WinT = (bf16_t*)(ws + WS_WIN); bf16_t* WattT = (bf16_t*)(ws + WS_WATT); bf16_t* WretT = (bf16_t*)(ws + WS_WRET); bf16_t* WoutT = (bf16_t*)(ws + WS_WOUT);
    bf16_t* W1T = (bf16_t*)(ws + WS_W1); bf16_t* W2T = (bf16_t*)(ws + WS_W2);
    float* tabA = (float*)(ws + WS_TABA); float* tabR = (float*)(ws + WS_TABR); float* ss1 = (float*)(ws + WS_SS1); float* ss2 = (float*)(ws + WS_SS2);
    bf16_t* XN = (bf16_t*)(ws + WS_XN); bf16_t* STATE = (bf16_t*)a.out; bf16_t* XN2 = XN;
    bf16_t* PROJ = (bf16_t*)(ws + WS_PROJ); bf16_t* HID = PROJ;
    volatile LAS unsigned* xb_st = (volatile LAS unsigned*)(lds + LDS_ST_OFF);
    if (tid < 2) xb_st[tid] = 0u;
    __syncthreads();
    if (bid == 0) { unsigned* ctl = (unsigned*)(ws + WS_CTL);
#pragma unroll
        for (int i = tid; i < (int)(CTL_BYTES / 4); i += NT) __hip_atomic_store(ctl + i, 0u, __ATOMIC_RELAXED, __HIP_MEMORY_SCOPE_AGENT); }
    asm volatile("s_waitcnt vmcnt(0)" ::: "memory");
    __syncthreads();
    grid.sync();
    const XcdBarrier xbar = xcd_barrier_post((unsigned*)(ws + WS_CTL), xb_st);
    {
        LAS float* scr = (LAS float*)(lds + wave * 16384);
        constexpr int I_IN = 16 * 184;
        for (int it = gw; it < I_IN; it += NGW) p0_transpose_item(a.in[2], 1024, 5888, WinT, scr, it, lane, true);
        const f32x4* gp = (const f32x4*)a.in[1] + lane;
        f32x4 gv[4];
#pragma unroll
        for (int j = 0; j < 4; ++j) gv[j] = gp[64 * j];
        for (int m = gw; m < M; m += 2 * NGW) {
            const int m2 = m + NGW;
            const f32x4* xr = (const f32x4*)(x + (size_t)m * D) + lane;
            const f32x4* xr2 = (const f32x4*)(x + (size_t)(m2 < M ? m2 : m) * D) + lane;
            f32x4 v[4], u[4]; float s = 0.f, s2 = 0.f;
#pragma unroll
            for (int j = 0; j < 4; ++j) { v[j] = xr[64 * j]; u[j] = xr2[64 * j]; }
#pragma unroll
            for (int j = 0; j < 4; ++j) { s += (v[j][0] * v[j][0] + v[j][1] * v[j][1]) + (v[j][2] * v[j][2] + v[j][3] * v[j][3]); s2 += (u[j][0] * u[j][0] + u[j][1] * u[j][1]) + (u[j][2] * u[j][2] + u[j][3] * u[j][3]); }
            const float rs = rsqrtf(wave_sum(s) * (1.0f / D) + 1e-6f), rs2 = rsqrtf(wave_sum(s2) * (1.0f / D) + 1e-6f);
            u32x2* o8 = (u32x2*)(XN + (size_t)m * D) + lane;
#pragma unroll
            for (int j = 0; j < 4; ++j) { u32x2 o; o.x = pk2(v[j][0] * rs * gv[j][0], v[j][1] * rs * gv[j][1]); o.y = pk2(v[j][2] * rs * gv[j][2], v[j][3] * rs * gv[j][3]); o8[64 * j] = o; }
            if (m2 < M) { u32x2* o9 = (u32x2*)(XN + (size_t)m2 * D) + lane;
#pragma unroll
                for (int j = 0; j < 4; ++j) { u32x2 o; o.x = pk2(u[j][0] * rs2 * gv[j][0], u[j][1] * rs2 * gv[j][1]); o.y = pk2(u[j][2] * rs2 * gv[j][2], u[j][3] * rs2 * gv[j][3]); o9[64 * j] = o; } }
        }
        const int gt = bid * NT + tid, NGT = G * NT;
        for (int e = gt; e < SEQ * 8; e += NGT) rope_entry(500000.0f, 16, e >> 3, e & 7, tabA + 2 * e);
        for (int e = gt; e < SEQ * 64; e += NGT) rope_entry(10000.0f, 128, e >> 6, e & 63, tabR + 2 * e);
        for (int e = gt; e < M; e += NGT) { ss1[e] = 0.f; ss2[e] = 0.f; }
    }
    XB_SYNC();
    {
        pg8::Gemm g{XN, WinT, M, PW, 1024, 1024}; pg8::StaticOrder S; S.init(M, PW, G, bid);
        pg8::EpiProj E{PROJ, a.in[3], tabA, tabR};
        pg8::gemm_phase<pg8::EpiProj, pg8::StaticOrder, true, true, 1024, 1024>(lds, g, S, E);
        {
            int nidle = 0, rank = -1;
            const int nwg = (M / 256) * (PW / 256), nr = (nwg + G - 1) / G, first_idle = nwg - (nr - 1) * G;
            if (first_idle < G) { nidle = G - first_idle; rank = bid - first_idle; } else { nidle = G; rank = bid; }
            if (rank >= 0) {
                LAS float* scr = (LAS float*)(lds + wave * 16384);
                constexpr int I_ATT = 8 * 32, I_RET = 16 * 32, I_OUT = 16 * 32, I_1 = 16 * 128, I_2 = 64 * 32, NLATE = I_ATT + I_RET + I_OUT + I_1 + I_2;
                for (int it = rank * 8 + wave; it < NLATE; it += nidle * 8) {
                    int r = it;
                    if (r < I_ATT) { p0_transpose_item(a.in[6], 512, 1024, WattT, scr, r, lane, false); continue; } r -= I_ATT;
                    if (r < I_RET) { p0_transpose_item(a.in[7], 1024, 1024, WretT, scr, r, lane, false); continue; } r -= I_RET;
                    if (r < I_OUT) { p0_transpose_item(a.in[8], 1024, 1024, WoutT, scr, r, lane, false); continue; } r -= I_OUT;
                    if (r < I_1) { p0_transpose_item(a.in[10], 1024, 4096, W1T, scr, r, lane, false); continue; } r -= I_1;
                    p0_transpose_item(a.in[11], 4096, 1024, W2T, scr, r, lane, false);
                }
                for (int it = rank; it < 128; it += nidle) pos0_partial(lds, x, a.in[1], a.in[2], (float*)(ws + WS_SX), it, tid);
            }
        }
    }
    XB_SYNC();
    {
        for (int u = bid; u < 768; u += G) {
            if (u < 256) { const int su = (G == 256) ? ((((u & 7) * 4 + ((u >> 3) >> 3)) << 3) | ((u >> 3) & 7)) : u; scan_unit(lds, PROJ, STATE, su, tid); }
            else attn_unit(lds, PROJ, a.in[4], u - 256, tid);
        }
    }
    XB_SYNC();
    for (int u = bid; u < 1024; u += G) retout_unit(lds, PROJ, STATE, a.in[5], u, tid, x, (const float*)(ws + WS_SX));
    XB_SYNC();
    {
        pg8::StaticOrder S; S.init(M, 1024, G, bid);
        { pg8::Gemm g{PROJ + SEC_QA, WattT, M, 1024, 512, 512}; pg8::EpiGateA E{PROJ}; pg8::gemm_phase<pg8::EpiGateA, pg8::StaticOrder, true, true, 512, 512>(lds, g, S, E); }
        { pg8::Gemm g{PROJ + SEC_GR, WretT, M, 1024, 1024, 1024}; pg8::EpiMerge E{PROJ}; pg8::gemm_phase<pg8::EpiMerge, pg8::StaticOrder, true, true, 1024, 1024>(lds, g, S, E); }
    }
    XB_SYNC();
    {
        pg8::StaticOrder S; S.init(M, 1024, G, bid);
        pg8::Gemm g{PROJ + SEC_GB, WoutT, M, 1024, 1024, 1024}; pg8::EpiOut E{x, a.out, XN2, a.in[9], ss1};
        pg8::gemm_phase<pg8::EpiOut, pg8::StaticOrder, true, true, 1024, 1024>(lds, g, S, E);
    }
    XB_SYNC();
    {
        pg8::StaticOrder S; S.init(M, FF, G, bid);
        pg8::Gemm g{XN2, W1T, M, FF, 1024, 1024}; pg8::EpiFF1 E{HID, ss1};
        pg8::gemm_phase<pg8::EpiFF1, pg8::StaticOrder, true, true, 1024, 1024>(lds, g, S, E);
    }
    XB_SYNC();
    {
        pg8::StaticOrder S; S.init(M, 1024, G, bid);
        pg8::Gemm g{HID, W2T, M, 1024, FF, FF}; pg8::EpiFF2 E{a.out, ss2};
        pg8::gemm_phase<pg8::EpiFF2, pg8::StaticOrder, true, true, FF, FF>(lds, g, S, E);
    }
    XB_SYNC();
    {
        int tid8 = threadIdx.x; asm volatile("" : "+v"(tid8)); int bid8 = blockIdx.x, G8 = gridDim.x; asm volatile("" : "+s"(bid8), "+s"(G8));
        const int lane = tid8 & 63, gw = bid8 * 8 + __builtin_amdgcn_readfirstlane(tid8 >> 6), NGW = G8 * 8;
        const f32x4* gp = (const f32x4*)a.in[12] + lane;
        f32x4 gv[4];
#pragma unroll
        for (int j = 0; j < 4; ++j) gv[j] = gp[64 * j];
        for (int m = gw; m < M; m += NGW) {
            const float rs = rsqrtf(ss2[m] * (1.0f / D) + 1e-6f);
            f32x4* xr = (f32x4*)(a.out + (size_t)m * D) + lane;
#pragma unroll
            for (int j = 0; j < 4; ++j) { f32x4 v = xr[64 * j]; v = v * rs * gv[j]; xr[64 * j] = v; }
        }
    }
}

extern "C" void kernel_launch(void* const* d_in, const int* in_sizes, int n_in, void* d_out, int out_size, void* d_ws, size_t ws_size, hipStream_t stream) {
    static int grid_blocks = 0;
    if (!grid_blocks) {
        if (n_in != 13 || in_sizes[0] != M * D || out_size != M * D || ws_size < WS_END) { fprintf(stderr, "kernel_launch: unexpected shapes / workspace (n_in %d, in0 %d, out %d, ws %zu)\n", n_in, n_in > 0 ? in_sizes[0] : -1, out_size, ws_size); grid_blocks = -1; return; }
        int dev = 0, cus = 0, per_cu = 0;
        hipGetDevice(&dev);
        hipDeviceGetAttribute(&cus, hipDeviceAttributeMultiprocessorCount, dev);
        hipFuncSetAttribute((const void*)mega, hipFuncAttributeMaxDynamicSharedMemorySize, LDS_BYTES);
        hipOccupancyMaxActiveBlocksPerMultiprocessor(&per_cu, (const void*)mega, NT, LDS_BYTES);
        if (per_cu < 1) { fprintf(stderr, "kernel_launch: occupancy query says %d blocks per CU\n", per_cu); per_cu = 1; }
        grid_blocks = cus;
    }
    if (grid_blocks < 0) return;
    Args a{};
    for (int i = 0; i < 13; ++i) a.in[i] = (const float*)d_in[i];
    a.out = (float*)d_out; a.ws = (unsigned char*)d_ws;
    void* args[] = {&a};
    hipError_t e = hipLaunchCooperativeKernel((void*)mega, dim3(grid_blocks), dim3(NT), args, LDS_BYTES, stream);
    if (e != hipSuccess) fprintf(stderr, "cooperative launch failed: %s (grid %d)\n", hipGetErrorString(e), grid_blocks);
}
```

```cpp
#include <hip/hip_runtime.h>
#include <hip/hip_cooperative_groups.h>
#include <cstdio>
#include <cstdint>
namespace cg = cooperative_groups;
namespace pg8 {
#define PG8_LAS __attribute__((address_space(3)))
typedef unsigned short bf16_t;
typedef short bf16x8 __attribute__((ext_vector_type(8)));
typedef float f32x4 __attribute__((ext_vector_type(4)));
typedef unsigned u32x4 __attribute__((ext_vector_type(4)));
constexpr int BM = 256, BK = 64, HALF = 128, HTB = HALF * BK * 2  , STAGE_BYTES = 8 * HTB, NXCD = 8, WGM = 8;

__host__ __device__ __forceinline__ int lds_byte(int r, int c) { const int st = (r >> 4) * 2 + (c >> 5), rr = r & 15, cc = c & 31, ob = rr * 64 + cc * 2; return st * 1024 + (ob ^ (((ob >> 9) & 1) << 5)); }
__host__ __device__ __forceinline__ void stage_rc(int b, int& R, int& C) { const int st = b / 1024, sb = b % 1024, swz = sb ^ (((sb >> 9) & 1) << 5); R = (st >> 1) * 16 + swz / 64; C = (st & 1) * 32 + (swz % 64) / 2; }
__host__ __device__ __forceinline__ int perm32(int rho) { const int n = rho >> 4, i = rho & 15; return 8 * (i >> 2) + 4 * n + (i & 3); }

struct Unit { int pm, pn; };
struct Gemm { const bf16_t* A; const bf16_t* Bt; int M, N, K, lda; };

struct StaticOrder {
    int nM, nN, nwg, G, c;
    __host__ __device__ void init(int M, int N, int G_, int c_) { nM = M / BM; nN = N / BM; nwg = nM * nN; G = G_; c = c_; }
    __host__ __device__ bool next(int i, Unit& u) const {
        const long L = (long)i * G + c; if (L >= nwg) return false;
        int wgid = (int)L; { const int q = nwg / NXCD, r = nwg % NXCD, xcd = wgid % NXCD, off = wgid / NXCD; wgid = (xcd < r ? xcd * (q + 1) : r * (q + 1) + (xcd - r) * q) + off; }
        const int nig = WGM * nN, gid = wgid / nig, fm = gid * WGM, gsz = (nM - fm) < WGM ? (nM - fm) : WGM;
        u.pm = fm + ((wgid % nig) % gsz); u.pn = (wgid % nig) / gsz; return true;
    }
    __device__ __forceinline__ void a_ready(const Unit&) const {}
    __device__ __forceinline__ void done(const Unit&) const {}
};

__device__ __forceinline__ unsigned pk2(float lo, float hi) { typedef float f2_t __attribute__((ext_vector_type(2))); typedef __bf16 b2_t __attribute__((ext_vector_type(2))); f2_t v = {lo, hi}; b2_t b = __builtin_convertvector(v, b2_t); return __builtin_bit_cast(unsigned, b); }
__device__ __forceinline__ float bflo(unsigned w) { return __uint_as_float(w << 16); }
__device__ __forceinline__ float bfhi(unsigned w) { return __uint_as_float(w & 0xffff0000u); }
__device__ __forceinline__ u32x4 pack8(const f32x4 v0, const f32x4 v1) { u32x4 w; w.x = pk2(v0[0], v0[1]); w.y = pk2(v0[2], v0[3]); w.z = pk2(v1[0], v1[1]); w.w = pk2(v1[2], v1[3]); return w; }
__device__ __forceinline__ float sigmoidf_(float v) { return __builtin_amdgcn_rcpf(1.0f + __expf(-v)); }

constexpr int PW = 5888;
constexpr size_t MROWS = 32768;
struct EpiProj {
    static constexpr bool PERM = true, AFTER_DRAIN = false;
    bf16_t* O; const float* bg; const float* tabA; const float* tabR;
    template <int TYPE, int cs, int ws> __device__ __forceinline__ void half(const f32x4 (&acc)[2][2][4][2], int bj, int row0, int col0) const {
        f32x4 b0 = (f32x4){0.f, 0.f, 0.f, 0.f}, b1 = b0;
        if (TYPE == 6) { b0 = *(const f32x4*)(bg + col0 - 3840); b1 = *(const f32x4*)(bg + col0 - 3840 + 4); }
        char* const sbase = (char*)(O + MROWS * cs); const unsigned boff0 = ((unsigned)row0 * (unsigned)ws + (unsigned)(col0 - cs)) * 2u;
        const bool ropeA = (TYPE <= 1) && ((col0 & 63) < 16);
        const int gA = (col0 & 63) >> 3, gR = (col0 & 127) >> 3;
#pragma unroll
        for (int ai = 0; ai < 2; ++ai)
#pragma unroll
            for (int m = 0; m < 4; ++m) {
                const int row = row0 + ai * HALF + m * 16, pos = row & 4095;
                f32x4 v0 = acc[ai][bj][m][0], v1 = acc[ai][bj][m][1];
                if (TYPE == 0 || TYPE == 1) {
                    if (ropeA) {
                        const f32x4* t = (const f32x4*)(tabA + ((size_t)pos * 8 + gA * 4) * 2); const f32x4 t0 = t[0], t1 = t[1];
                        const f32x4 cv = (f32x4){t0[0], t0[2], t1[0], t1[2]}, sn = (f32x4){t0[1], t0[3], t1[1], t1[3]};
                        const f32x4 a = v0 * cv - v1 * sn, bb = v1 * cv + v0 * sn; v0 = a; v1 = bb;
                    }
                    if (TYPE == 0) { v0 = v0 * 0.125f; v1 = v1 * 0.125f; }
                } else if (TYPE == 3 || TYPE == 4) {
                    const f32x4* t = (const f32x4*)(tabR + ((size_t)pos * 64 + gR * 4) * 2); const f32x4 t0 = t[0], t1 = t[1];
                    const f32x4 cv = (f32x4){t0[0], t0[2], t1[0], t1[2]}, sn = (f32x4){t0[1], t0[3], t1[1], t1[3]};
                    const f32x4 a = v0 * cv - v1 * sn, bb = v1 * cv + v0 * sn; v0 = a; v1 = bb;
                    if (TYPE == 4) { v0 = v0 * 0.08838834764831845f; v1 = v1 * 0.08838834764831845f; }
                } else if (TYPE == 5) {
#pragma unroll
                    for (int e = 0; e < 4; ++e) { v0[e] = v0[e] * sigmoidf_(v0[e]); v1[e] = v1[e] * sigmoidf_(v1[e]); }
                } else if (TYPE == 6) {
#pragma unroll
                    for (int e = 0; e < 4; ++e) { v0[e] = sigmoidf_(v0[e] + b0[e]); v1[e] = sigmoidf_(v1[e] + b1[e]); }
                }
                *(u32x4*)(sbase + (boff0 + (unsigned)((ai * HALF + m * 16) * ws * 2))) = pack8(v0, v1);
            }
    }
    __device__ __forceinline__ void operator()(const f32x4 (&acc)[2][2][4][2], const Unit& u, int wr, int wc, int fr, int fq) const {
        const int row0 = u.pm * BM + wr * 64 + fr;
#pragma unroll
        for (int bj = 0; bj < 2; ++bj) {
            const int colbase = u.pn * BM + bj * HALF, sec = colbase >> 7, col0 = colbase + wc * 32 + 8 * fq;
            if (sec < 4) half<0, 0, 512>(acc, bj, row0, col0);
            else if (sec == 4) half<1, 512, 128>(acc, bj, row0, col0);
            else if (sec == 5) half<2, 640, 128>(acc, bj, row0, col0);
            else if (sec < 10) half<3, 768, 512>(acc, bj, row0, col0);
            else if (sec < 14) half<4, 1280, 512>(acc, bj, row0, col0);
            else if (sec < 22) half<2, 1792, 1024>(acc, bj, row0, col0);
            else if (sec < 30) half<5, 2816, 1024>(acc, bj, row0, col0);
            else if (sec < 38) half<6, 3840, 1024>(acc, bj, row0, col0);
            else half<6, 4864, 1024>(acc, bj, row0, col0);
        }
    }
};
#define EPI_CV(V_) (f32x4){bflo((V_).x), bfhi((V_).x), bflo((V_).y), bfhi((V_).y)}, (f32x4){bflo((V_).z), bfhi((V_).z), bflo((V_).w), bfhi((V_).w)}
struct EpiGateA {
    static constexpr bool PERM = true, AFTER_DRAIN = false;
    bf16_t* P;
    __device__ __forceinline__ void operator()(const f32x4 (&acc)[2][2][4][2], const Unit& u, int wr, int wc, int fr, int fq) const {
        const int row0 = u.pm * BM + wr * 64 + fr, colw = u.pn * BM + wc * 32 + 8 * fq;
        bf16_t* const base = P + MROWS * 3840 + (size_t)row0 * 1024 + colw;
#pragma unroll
        for (int ai = 0; ai < 2; ++ai)
#pragma unroll
            for (int mp = 0; mp < 2; ++mp) {
                u32x4 g[2][2];
#pragma unroll
                for (int mm = 0; mm < 2; ++mm)
#pragma unroll
                    for (int bj = 0; bj < 2; ++bj) g[mm][bj] = *(const u32x4*)(base + (size_t)(ai * HALF + (2 * mp + mm) * 16) * 1024 + bj * HALF);
#pragma unroll
                for (int mm = 0; mm < 2; ++mm)
#pragma unroll
                    for (int bj = 0; bj < 2; ++bj) { const int m = 2 * mp + mm; const f32x4 gg[2] = {EPI_CV(g[mm][bj])};
                        *(u32x4*)(base + (size_t)(ai * HALF + m * 16) * 1024 + bj * HALF) = pack8(acc[ai][bj][m][0] * gg[0], acc[ai][bj][m][1] * gg[1]); }
            }
    }
};
struct EpiMerge {
    static constexpr bool PERM = true, AFTER_DRAIN = false;
    bf16_t* P;
    __device__ __forceinline__ void operator()(const f32x4 (&acc)[2][2][4][2], const Unit& u, int wr, int wc, int fr, int fq) const {
        const int row0 = u.pm * BM + wr * 64 + fr, colw = u.pn * BM + wc * 32 + 8 * fq;
        const bf16_t* const tb = P + MROWS * 3840 + (size_t)row0 * 1024 + colw; bf16_t* const gb = P + MROWS * 4864 + (size_t)row0 * 1024 + colw;
#pragma unroll
        for (int ai = 0; ai < 2; ++ai)
#pragma unroll
            for (int mp = 0; mp < 2; ++mp) {
                u32x4 t[2][2], g[2][2];
#pragma unroll
                for (int mm = 0; mm < 2; ++mm)
#pragma unroll
                    for (int bj = 0; bj < 2; ++bj) { const size_t o = (size_t)(ai * HALF + (2 * mp + mm) * 16) * 1024 + bj * HALF; t[mm][bj] = *(const u32x4*)(tb + o); g[mm][bj] = *(const u32x4*)(gb + o); }
#pragma unroll
                for (int mm = 0; mm < 2; ++mm)
#pragma unroll
                    for (int bj = 0; bj < 2; ++bj) { const int m = 2 * mp + mm; const size_t o = (size_t)(ai * HALF + m * 16) * 1024 + bj * HALF;
                        const f32x4 gg[2] = {EPI_CV(g[mm][bj])}, tt[2] = {EPI_CV(t[mm][bj])};
                        *(u32x4*)(gb + o) = pack8(tt[0] + acc[ai][bj][m][0] * gg[0], tt[1] + acc[ai][bj][m][1] * gg[1]); }
            }
    }
};
struct EpiOut {
    static constexpr bool PERM = true, AFTER_DRAIN = false;
    const float* x; float* h1; bf16_t* xn2; const float* gain; float* ss;
    __device__ __forceinline__ void operator()(const f32x4 (&acc)[2][2][4][2], const Unit& u, int wr, int wc, int fr, int fq) const {
        const int row0 = u.pm * BM + wr * 64 + fr, colw = u.pn * BM + wc * 32 + 8 * fq;
        f32x4 gn[2][2];
#pragma unroll
        for (int bj = 0; bj < 2; ++bj) { gn[bj][0] = *(const f32x4*)(gain + colw + bj * HALF); gn[bj][1] = *(const f32x4*)(gain + colw + bj * HALF + 4); }
#pragma unroll
        for (int ai = 0; ai < 2; ++ai)
#pragma unroll
            for (int mp = 0; mp < 2; ++mp) {
                f32x4 xv[2][2][2];
#pragma unroll
                for (int mm = 0; mm < 2; ++mm)
#pragma unroll
                    for (int bj = 0; bj < 2; ++bj) { const size_t off = (size_t)(row0 + ai * HALF + (2 * mp + mm) * 16) * 1024 + colw + bj * HALF; xv[mm][bj][0] = *(const f32x4*)(x + off); xv[mm][bj][1] = *(const f32x4*)(x + off + 4); }
#pragma unroll
                for (int mm = 0; mm < 2; ++mm) {
                    const int m = 2 * mp + mm, row = row0 + ai * HALF + m * 16; float sq = 0.f;
#pragma unroll
                    for (int bj = 0; bj < 2; ++bj) { const size_t off = (size_t)row * 1024 + colw + bj * HALF;
                        const f32x4 ha = xv[mm][bj][0] + acc[ai][bj][m][0], hb = xv[mm][bj][1] + acc[ai][bj][m][1];
                        *(f32x4*)(h1 + off) = ha; *(f32x4*)(h1 + off + 4) = hb;
                        sq += (ha[0] * ha[0] + ha[1] * ha[1]) + (ha[2] * ha[2] + ha[3] * ha[3]) + (hb[0] * hb[0] + hb[1] * hb[1]) + (hb[2] * hb[2] + hb[3] * hb[3]);
                        *(u32x4*)(xn2 + off) = pack8(ha * gn[bj][0], hb * gn[bj][1]); }
                    asm volatile("s_nop 4" : "+v"(sq)); sq += __shfl_xor(sq, 16); asm volatile("s_nop 4" : "+v"(sq)); sq += __shfl_xor(sq, 32);
                    if (fq == 0) atomicAdd(ss + row, sq);
                }
            }
    }
};
struct EpiFF1 {
    static constexpr bool PERM = true, AFTER_DRAIN = false;
    bf16_t* hid; const float* ss;
    __device__ __forceinline__ void operator()(const f32x4 (&acc)[2][2][4][2], const Unit& u, int wr, int wc, int fr, int fq) const {
        const int row0 = u.pm * BM + wr * 64 + fr;
        float rr[2][4];
#pragma unroll
        for (int ai = 0; ai < 2; ++ai)
#pragma unroll
            for (int m = 0; m < 4; ++m) rr[ai][m] = ss[row0 + ai * HALF + m * 16];
#pragma unroll
        for (int ai = 0; ai < 2; ++ai)
#pragma unroll
            for (int m = 0; m < 4; ++m) {
                const int row = row0 + ai * HALF + m * 16; const float r = rsqrtf(rr[ai][m] * (1.0f / 1024.0f) + 1e-6f);
#pragma unroll
                for (int bj = 0; bj < 2; ++bj) {
                    const int col0 = u.pn * BM + bj * HALF + wc * 32 + 8 * fq;
                    f32x4 v0 = acc[ai][bj][m][0] * r, v1 = acc[ai][bj][m][1] * r;
#pragma unroll
                    for (int e = 0; e < 4; ++e) { const float a = fmaxf(v0[e], 0.f), b = fmaxf(v1[e], 0.f); v0[e] = a * a; v1[e] = b * b; }
                    *(u32x4*)(hid + (size_t)row * 4096 + col0) = pack8(v0, v1);
                }
            }
    }
};
struct EpiFF2 {
    static constexpr bool PERM = true, AFTER_DRAIN = false;
    float* h; float* ss;
    __device__ __forceinline__ void operator()(const f32x4 (&acc)[2][2][4][2], const Unit& u, int wr, int wc, int fr, int fq) const {
        const int row0 = u.pm * BM + wr * 64 + fr, colw = u.pn * BM + wc * 32 + 8 * fq;
#pragma unroll
        for (int ai = 0; ai < 2; ++ai)
#pragma unroll
            for (int mp = 0; mp < 2; ++mp) {
                f32x4 hv[2][2][2];
#pragma unroll
                for (int mm = 0; mm < 2; ++mm)
#pragma unroll
                    for (int bj = 0; bj < 2; ++bj) { const size_t off = (size_t)(row0 + ai * HALF + (2 * mp + mm) * 16) * 1024 + colw + bj * HALF; hv[mm][bj][0] = *(const f32x4*)(h + off); hv[mm][bj][1] = *(const f32x4*)(h + off + 4); }
#pragma unroll
                for (int mm = 0; mm < 2; ++mm) {
                    const int m = 2 * mp + mm, row = row0 + ai * HALF + m * 16; float sq = 0.f;
#pragma unroll
                    for (int bj = 0; bj < 2; ++bj) { const size_t off = (size_t)row * 1024 + colw + bj * HALF;
                        const f32x4 ha = hv[mm][bj][0] + acc[ai][bj][m][0], hb = hv[mm][bj][1] + acc[ai][bj][m][1];
                        *(f32x4*)(h + off) = ha; *(f32x4*)(h + off + 4) = hb;
                        sq += (ha[0] * ha[0] + ha[1] * ha[1]) + (ha[2] * ha[2] + ha[3] * ha[3]) + (hb[0] * hb[0] + hb[1] * hb[1]) + (hb[2] * hb[2] + hb[3] * hb[3]); }
                    asm volatile("s_nop 4" : "+v"(sq)); sq += __shfl_xor(sq, 16); asm volatile("s_nop 4" : "+v"(sq)); sq += __shfl_xor(sq, 32);
                    if (fq == 0) atomicAdd(ss + row, sq);
                }
            }
    }
};

template <class Epi, class Sched, bool ALIGN_EPI, bool SP2, int KC, int LDAC>
__device__ __forceinline__ void gemm_phase(PG8_LAS unsigned char* lds, const Gemm g, const Sched& S, const Epi& E) {
    int tid_ = threadIdx.x; asm volatile("" : "+v"(tid_)); const int tid = tid_, wid = __builtin_amdgcn_readfirstlane(tid >> 6), lane = tid & 63, wr = wid >> 2, wc = wid & 3, fr = lane & 15, fq = lane >> 4;
    constexpr int K = KC, nt = KC / BK, lda = LDAC;
    unsigned voffA[2], voffB[2];
#pragma unroll
    for (int i = 0; i < 2; ++i) { int R, C; stage_rc(tid * 16 + i * 8192, R, C); const int Rb = Epi::PERM ? ((R & ~31) + perm32(R & 31)) : R;
        voffA[i] = (unsigned)(R * lda + C) * 2u; voffB[i] = (unsigned)(Rb * K + C) * 2u; }
    const size_t kstep = (size_t)(BK * 2);
    const size_t hstepA = (size_t)HALF * lda * 2, hstepB = (size_t)HALF * K * 2;
    const size_t tstepA = 2 * hstepA, tstepB = 2 * hstepB;
    const unsigned ldsw = (unsigned)wid * 1024u;
    const int aoff = lds_byte(wr * 64 + fr, fq * 8), boff = lds_byte(wc * 32 + fr, fq * 8);
#define PG8_SA(b, h) (((b) * 2 + (h)) * HTB)
#define PG8_SB(b, h) ((4 + (b) * 2 + (h)) * HTB)
#define PG8_STAGE(bufoff, gbase, voff) do { _Pragma("unroll") for (int _i = 0; _i < 2; ++_i) \
        __builtin_amdgcn_global_load_lds((const unsigned*)((const char*)(gbase) + (voff)[_i]), (PG8_LAS unsigned*)(lds + (bufoff) + ldsw + _i * 8192), 16, 0, 0); } while (0)
#define PG8_LDA(dst, b, h) do { _Pragma("unroll") for (int m = 0; m < 4; ++m) _Pragma("unroll") for (int k = 0; k < 2; ++k) dst[m][k] = *(const PG8_LAS bf16x8*)(lds + PG8_SA(b, h) + aoff + m * 2048 + k * 1024); } while (0)
#define PG8_LDB(dst, b, h) do { _Pragma("unroll") for (int n = 0; n < 2; ++n) _Pragma("unroll") for (int k = 0; k < 2; ++k) dst[n][k] = *(const PG8_LAS bf16x8*)(lds + PG8_SB(b, h) + boff + n * 2048 + k * 1024); } while (0)
#define PG8_MMA(ai, bj, At, Bt) do { __builtin_amdgcn_s_setprio(1); _Pragma("unroll") for (int m = 0; m < 4; ++m) _Pragma("unroll") for (int n = 0; n < 2; ++n) _Pragma("unroll") for (int k = 0; k < 2; ++k) \
        acc[ai][bj][m][n] = __builtin_amdgcn_mfma_f32_16x16x32_bf16(Bt[n][k], At[m][k], acc[ai][bj][m][n], 0, 0, 0); __builtin_amdgcn_s_setprio(0); } while (0)
#define PG8_WAIT_V(n) asm volatile("s_waitcnt vmcnt(" #n ")" ::: "memory")
#define PG8_WAIT_L(n) asm volatile("s_waitcnt lgkmcnt(" #n ")" ::: "memory")
#define PG8_BAR __builtin_amdgcn_s_barrier()
#define PG8_SCHED __builtin_amdgcn_sched_barrier(0)
    Unit cur, nxt; int ui = 0;
    if (!S.next(0, cur)) return;
    f32x4 acc[2][2][4][2];
#pragma unroll
    for (int a = 0; a < 2; ++a)
#pragma unroll
        for (int b = 0; b < 2; ++b)
#pragma unroll
            for (int m = 0; m < 4; ++m)
#pragma unroll
                for (int n = 0; n < 2; ++n) acc[a][b][m][n] = (f32x4){0.f, 0.f, 0.f, 0.f};
    bf16x8 At[4][2], B0[2][2], B1[2][2];
    const char* cA = (const char*)g.A + (size_t)cur.pm * tstepA; const char* cB = (const char*)g.Bt + (size_t)cur.pn * tstepB;
    S.a_ready(cur);
    if constexpr (SP2) {
        PG8_STAGE(PG8_SB(0, 0), cB, voffB); PG8_STAGE(PG8_SB(0, 1), cB + hstepB, voffB); PG8_STAGE(PG8_SA(0, 0), cA, voffA); PG8_STAGE(PG8_SA(0, 1), cA + hstepA, voffA);
        if (wr == 1) PG8_BAR;
        PG8_WAIT_V(2); PG8_BAR;
        PG8_STAGE(PG8_SB(1, 0), cB + kstep, voffB); PG8_STAGE(PG8_SA(1, 0), cA + kstep, voffA); PG8_STAGE(PG8_SB(1, 1), cB + hstepB + kstep, voffB);
        PG8_WAIT_V(6); PG8_BAR;
    } else {
        PG8_STAGE(PG8_SB(0, 0), cB, voffB); PG8_STAGE(PG8_SA(0, 0), cA, voffA); PG8_STAGE(PG8_SB(0, 1), cB + hstepB, voffB); PG8_STAGE(PG8_SA(0, 1), cA + hstepA, voffA);
        if (wr == 1) PG8_BAR;
        PG8_WAIT_V(4); PG8_BAR;
        PG8_STAGE(PG8_SB(1, 0), cB + kstep, voffB); PG8_STAGE(PG8_SA(1, 0), cA + kstep, voffA); PG8_STAGE(PG8_SB(1, 1), cB + hstepB + kstep, voffB);
        PG8_WAIT_V(6); PG8_BAR;
    }
    for (;;) {
        const bool has_next = S.next(ui + 1, nxt);
        const char* nA = has_next ? (const char*)g.A + (size_t)nxt.pm * tstepA : cA; const char* nB = has_next ? (const char*)g.Bt + (size_t)nxt.pn * tstepB : cB;
        for (int t = 0; t < nt; t += 2) {
            const bool last = (t == nt - 2);
            const char* a1 = cA + (size_t)(t + 1) * kstep;
            const char* a2 = last ? nA : cA + (size_t)(t + 2) * kstep; const char* b2 = last ? nB : cB + (size_t)(t + 2) * kstep;
            const char* a3 = a2 + kstep; const char* b3 = b2 + kstep;
            if (last && has_next) S.a_ready(nxt);
            if constexpr (SP2) {
            PG8_LDB(B0, 0, 0); PG8_LDB(B1, 0, 1); PG8_SCHED; PG8_LDA(At, 0, 0); PG8_STAGE(PG8_SA(1, 1), a1 + hstepA, voffA);
            PG8_WAIT_V(8); PG8_WAIT_L(0); PG8_BAR; PG8_MMA(0, 0, At, B0); PG8_MMA(0, 1, At, B1); PG8_BAR; PG8_SCHED;
            PG8_LDA(At, 0, 1); PG8_STAGE(PG8_SB(0, 0), b2, voffB); PG8_STAGE(PG8_SB(0, 1), b2 + hstepB, voffB); PG8_STAGE(PG8_SA(0, 0), a2, voffA);
            PG8_WAIT_V(8); PG8_WAIT_L(0); PG8_BAR; PG8_MMA(1, 0, At, B0); PG8_MMA(1, 1, At, B1); PG8_BAR; PG8_SCHED;
            PG8_LDB(B0, 1, 0); PG8_LDB(B1, 1, 1); PG8_SCHED; PG8_LDA(At, 1, 0); PG8_STAGE(PG8_SA(0, 1), a2 + hstepA, voffA);
            PG8_WAIT_V(8); PG8_WAIT_L(0); PG8_BAR; PG8_MMA(0, 0, At, B0); PG8_MMA(0, 1, At, B1); PG8_BAR; PG8_SCHED;
            PG8_LDA(At, 1, 1); PG8_STAGE(PG8_SB(1, 0), b3, voffB); PG8_STAGE(PG8_SB(1, 1), b3 + hstepB, voffB); PG8_STAGE(PG8_SA(1, 0), a3, voffA);
            PG8_WAIT_V(8); PG8_WAIT_L(0); PG8_BAR; PG8_MMA(1, 0, At, B0); PG8_MMA(1, 1, At, B1); PG8_BAR; PG8_SCHED;
            } else {
            PG8_LDB(B0, 0, 0); PG8_SCHED; PG8_LDA(At, 0, 0); PG8_STAGE(PG8_SA(1, 1), a1 + hstepA, voffA);
            PG8_WAIT_L(8); PG8_BAR; PG8_WAIT_L(0); PG8_MMA(0, 0, At, B0); PG8_BAR; PG8_SCHED;
            PG8_LDB(B1, 0, 1); PG8_STAGE(PG8_SB(0, 0), b2, voffB);
            PG8_BAR; PG8_WAIT_L(0); PG8_MMA(0, 1, At, B1); PG8_BAR;
            PG8_LDA(At, 0, 1); PG8_STAGE(PG8_SA(0, 0), a2, voffA);
            PG8_BAR; PG8_WAIT_L(0); PG8_MMA(1, 0, At, B0); PG8_BAR; PG8_SCHED;
            PG8_STAGE(PG8_SB(0, 1), b2 + hstepB, voffB);
            PG8_WAIT_V(6); PG8_BAR; PG8_MMA(1, 1, At, B1); PG8_BAR;
            PG8_LDB(B0, 1, 0); PG8_SCHED; PG8_LDA(At, 1, 0); PG8_STAGE(PG8_SA(0, 1), a2 + hstepA, voffA);
            PG8_WAIT_L(8); PG8_BAR; PG8_WAIT_L(0); PG8_MMA(0, 0, At, B0); PG8_BAR; PG8_SCHED;
            PG8_LDB(B1, 1, 1); PG8_STAGE(PG8_SB(1, 0), b3, voffB);
            PG8_BAR; PG8_WAIT_L(0); PG8_MMA(0, 1, At, B1); PG8_BAR;
            PG8_LDA(At, 1, 1); PG8_STAGE(PG8_SA(1, 0), a3, voffA);
            PG8_BAR; PG8_WAIT_L(0); PG8_MMA(1, 0, At, B0); PG8_BAR; PG8_SCHED;
            PG8_STAGE(PG8_SB(1, 1), b3 + hstepB, voffB);
            PG8_WAIT_V(6); PG8_BAR; PG8_MMA(1, 1, At, B1); PG8_BAR;
            }
        }
        if constexpr (ALIGN_EPI) { if (wr == 0) PG8_BAR; }
        if constexpr (!Epi::AFTER_DRAIN) { E(acc, cur, wr, wc, fr, fq); S.done(cur); }
        if (!has_next) break;
#pragma unroll
        for (int a = 0; a < 2; ++a)
#pragma unroll
            for (int b = 0; b < 2; ++b)
#pragma unroll
                for (int m = 0; m < 4; ++m)
#pragma unroll
                    for (int n = 0; n < 2; ++n) acc[a][b][m][n] = (f32x4){0.f, 0.f, 0.f, 0.f};
        cur = nxt; cA = nA; cB = nB; ++ui;
        if constexpr (ALIGN_EPI) { if (wr == 1) PG8_BAR; }
    }
    PG8_WAIT_V(0);
    if constexpr (!ALIGN_EPI) { if (wr == 0) PG8_BAR; }
    PG8_BAR;
    if constexpr (Epi::AFTER_DRAIN) { E.fused(acc, cur, wr, wc, fr, fq, lds, wid, lane); S.done(cur); }
#undef PG8_SA
#undef PG8_SB
#undef PG8_STAGE
#undef PG8_LDA
#undef PG8_LDB
#undef PG8_MMA
#undef PG8_WAIT_V
#undef PG8_WAIT_L
#undef PG8_BAR
#undef PG8_SCHED
}
}

#define LAS __attribute__((address_space(3)))
typedef unsigned short bf16_t;
typedef unsigned u32x4 __attribute__((ext_vector_type(4)));
typedef unsigned u32x2 __attribute__((ext_vector_type(2)));
typedef float f32x4 __attribute__((ext_vector_type(4)));
typedef float f32x16 __attribute__((ext_vector_type(16)));
typedef short bf16x8 __attribute__((ext_vector_type(8)));
typedef short s16x4 __attribute__((ext_vector_type(4)));
using pg8::pk2;

constexpr int NT = 512;
constexpr int LDS_BYTES = 147456;
constexpr int M = 32768, D = 1024, SEQ = 4096, PW = 5888, FF = 4096;
constexpr size_t MiB = 1u << 20;
constexpr size_t SEC_QA = 0, SEC_KA = (size_t)M * 512, SEC_VA = (size_t)M * 640, SEC_QR = (size_t)M * 768, SEC_KR = (size_t)M * 1280, SEC_VR = (size_t)M * 1792, SEC_GR = (size_t)M * 2816, SEC_GB = (size_t)M * 4864;
constexpr size_t WS_WIN = 0, WS_WATT = 12 * MiB, WS_WRET = 13 * MiB, WS_WOUT = 15 * MiB, WS_W1 = 17 * MiB, WS_W2 = 25 * MiB;
constexpr size_t WS_TABA = 33 * MiB, WS_TABR = 34 * MiB, WS_SS1 = 36 * MiB, WS_SS2 = 36 * MiB + 512 * 1024;
constexpr size_t WS_CTL = 37 * MiB, CTL_BYTES = 16384;
constexpr int LDS_ST_OFF = LDS_BYTES - 16;
constexpr size_t WS_SX = 38 * MiB;
constexpr size_t WS_XN = 40 * MiB;
constexpr size_t WS_PROJ = 104 * MiB;
constexpr size_t WS_END = 472 * MiB;

struct Args { const float* in[13]; float* out; unsigned char* ws; };
#define XB_SYNC() xcd_barrier(xbar)

__device__ __forceinline__ float settle(float v) { asm volatile("s_nop 4" : "+v"(v)); return v; }
__device__ __forceinline__ float wave_sum(float v) {
#pragma unroll
    for (int o = 1; o < 64; o <<= 1) { v = settle(v); v += __shfl_xor(v, o); }
    return v;
}
__device__ __forceinline__ float ex2(float v) { return __builtin_amdgcn_exp2f(v); }
template <int CTRL> __device__ __forceinline__ float dpp_f(float v) { return __builtin_bit_cast(float, __builtin_amdgcn_update_dpp(0, __builtin_bit_cast(int, v), CTRL, 0xF, 0xF, false)); }
__device__ __forceinline__ float rsum16(float v) { v = settle(v); v += dpp_f<0xB1>(v); v = settle(v); v += dpp_f<0x4E>(v); v = settle(v); v += dpp_f<0x124>(v); v = settle(v); v += dpp_f<0x128>(v); return settle(v); }
__device__ __forceinline__ int crow(int r, int hi) { return (r & 3) + 8 * (r >> 2) + 4 * hi; }


#define XB_TMO      128
#define XB_XCNT(j)  (256  + 64 * (j))
#define XB_XSUB(j)  (1280 + 64 * (j))
#define XB_XGEN(j)  (2304 + 64 * (j))
#define XB_TOP      3328
#define XB_TOPGEN   3392
#define XCD_BAR_WORDS 3456
#define XB_SPIN_CAP (1u << 18)
__device__ __forceinline__ unsigned xb_ld(unsigned* p)              { return __hip_atomic_load(p, __ATOMIC_RELAXED, __HIP_MEMORY_SCOPE_AGENT); }
__device__ __forceinline__ unsigned xb_add(unsigned* p, unsigned v) { return __hip_atomic_fetch_add(p, v, __ATOMIC_RELAXED, __HIP_MEMORY_SCOPE_AGENT); }
__device__ __forceinline__ unsigned xb_xcc_id() { return (unsigned)__builtin_amdgcn_s_getreg((3 << 11) | 20) & 0xFu; }
#define XB_SPIN(cond, bar) do { unsigned _sp = 0; while (cond) { __builtin_amdgcn_s_sleep(1); \
    if ((++_sp & 255u) == 0u) { if (xb_ld(&(bar)[XB_TMO])) break; if (_sp > XB_SPIN_CAP) { atomicAdd(&(bar)[XB_TMO], 1u); break; } } } } while (0)
struct XcdBarrier { unsigned* bar; unsigned x; volatile LAS unsigned* st; };
__device__ __forceinline__ XcdBarrier xcd_barrier_post(unsigned* bar, volatile LAS unsigned* st) {
    XcdBarrier b; b.bar = bar; b.x = xb_xcc_id(); b.st = st;
    if (threadIdx.x == 0) (void)xb_add(&bar[XB_XCNT(b.x)], 1u);
    return b;
}
__device__ __forceinline__ void xcd_barrier_complete(unsigned* bar, unsigned x, unsigned& nloc, unsigned& nx) {
    const unsigned G = gridDim.x * gridDim.y * gridDim.z;
    unsigned sum, cnt, mine, sp = 0u;
    for (;;) {
        sum = 0u; cnt = 0u; mine = 0u;
#pragma unroll
        for (unsigned j = 0; j < 16; ++j) { const unsigned c = xb_ld(&bar[XB_XCNT(j)]); sum += c; cnt += (c > 0u) ? 1u : 0u; mine = (j == x) ? c : mine; }
        if (sum == G) break;
        __builtin_amdgcn_s_sleep(1);
        if ((++sp & 255u) == 0u) { if (xb_ld(&bar[XB_TMO])) break; if (sp > XB_SPIN_CAP) { atomicAdd(&bar[XB_TMO], 1u); break; } }
    }
    nloc = mine > 0u ? mine : 1u; nx = cnt > 0u ? cnt : 1u;
}
__device__ __forceinline__ void xcd_barrier(const XcdBarrier& b) {
    asm volatile("s_waitcnt vmcnt(0)" ::: "memory");
    __syncthreads();
    if (threadIdx.x == 0) {
        unsigned* bar = b.bar;
        __builtin_amdgcn_s_waitcnt(0);
        unsigned nloc = b.st[0], nx = b.st[1];
        if (nloc == 0u) { xcd_barrier_complete(bar, b.x, nloc, nx); b.st[0] = nloc; b.st[1] = nx; }
        const unsigned old = xb_add(&bar[XB_XSUB(b.x)], 1u);
        const unsigned gen = old / nloc;
        if (old + 1u == (gen + 1u) * nloc) {
            __builtin_amdgcn_fence(__ATOMIC_RELEASE, "agent");
            asm volatile("s_waitcnt vmcnt(0)" ::: "memory");
            const unsigned og = xb_add(&bar[XB_TOP], 1u);
            const unsigned tg = og / nx;
            if (og + 1u == (tg + 1u) * nx) xb_add(&bar[XB_TOPGEN], 1u);
            else XB_SPIN(xb_ld(&bar[XB_TOPGEN]) == tg, bar);
            __builtin_amdgcn_fence(__ATOMIC_ACQUIRE, "");
            asm volatile("s_waitcnt vmcnt(0)" ::: "memory");
            xb_add(&bar[XB_XGEN(b.x)], 1u);
        } else {
            XB_SPIN(xb_ld(&bar[XB_XGEN(b.x)]) == gen, bar);
            __builtin_amdgcn_fence(__ATOMIC_ACQUIRE, "agent");
            asm volatile("s_waitcnt vmcnt(0)" ::: "memory");
        }
    }
    __syncthreads();
}

__device__ __forceinline__ int src_col(int n) {
    if (n < 640) { const int p = n & 63; if (p < 16) { const int g = p >> 3, w = p & 7; return (n & ~63) + ((w < 4) ? (4 * g + w) : (8 + 4 * g + (w - 4))); } return n; }
    if (n >= 768 && n < 1792) { const int p = n & 127, g = p >> 3, w = p & 7; return (n & ~127) + ((w < 4) ? (4 * g + w) : (64 + 4 * g + (w - 4))); }
    return n;
}
__device__ __forceinline__ void p0_transpose_item(const float* W, int K, int N, bf16_t* WT, LAS float* scr, int item, int lane, bool perm) {
    const int nblk = N / 32, kb = item / nblk, nb = item % nblk, k0 = 64 * kb, n0 = 32 * nb;
    const int ncol = perm ? src_col(n0 + (lane & 31)) : (n0 + (lane & 31));
#pragma unroll
    for (int i = 0; i < 32; ++i) { const int kk = 2 * i + (lane >> 5); scr[kk * 33 + (lane & 31)] = W[(size_t)(k0 + kk) * N + ncol]; }
    asm volatile("s_waitcnt lgkmcnt(0)" ::: "memory");
    const int c = lane & 7;
#pragma unroll
    for (int j = 0; j < 4; ++j) { const int n = (lane >> 3) + 8 * j; const LAS float* s = scr + (8 * c) * 33 + n;
        u32x4 o; o.x = pk2(s[0 * 33], s[1 * 33]); o.y = pk2(s[2 * 33], s[3 * 33]); o.z = pk2(s[4 * 33], s[5 * 33]); o.w = pk2(s[6 * 33], s[7 * 33]);
        *(u32x4*)(WT + (size_t)(n0 + n) * K + k0 + 8 * c) = o; }
    asm volatile("s_waitcnt lgkmcnt(0)" ::: "memory");
}
__device__ __forceinline__ void rope_entry(float theta, int dim, int pos, int i, float* out2) {
    const float e = -(float)(2 * i) / (float)dim;
    const float inv_freq = (float)exp((double)e * log((double)theta));
    const float ang = (float)pos * inv_freq;
    const double a = (double)ang;
    const double qd = rint(a * 0.63661977236758134308);
    const double r = a - qd * 1.57079632679489661923, r2 = r * r;
    const double sn = r * (1.0 - r2 / 6.0 * (1.0 - r2 / 20.0 * (1.0 - r2 / 42.0 * (1.0 - r2 / 72.0 * (1.0 - r2 / 110.0 * (1.0 - r2 / 156.0))))));
    const double cs = 1.0 - r2 / 2.0 * (1.0 - r2 / 12.0 * (1.0 - r2 / 30.0 * (1.0 - r2 / 56.0 * (1.0 - r2 / 90.0 * (1.0 - r2 / 132.0 * (1.0 - r2 / 182.0))))));
    const int qq = ((int)qd) & 3;
    double c2 = cs, s2 = sn;
    if (qq == 1) { c2 = -sn; s2 = cs; } else if (qq == 2) { c2 = -cs; s2 = -sn; } else if (qq == 3) { c2 = sn; s2 = -cs; }
    out2[0] = (float)c2; out2[1] = (float)s2;
}

__device__ __forceinline__ void attn_unit(LAS unsigned char* lds, bf16_t* P, const float* sinks, int unit, int tid) {
    asm volatile("" : "+v"(tid));
    const int lane = tid & 63, w = __builtin_amdgcn_readfirstlane(tid >> 6), r32 = lane & 31, h = lane >> 5;
    const int blk = unit & 31, kvh = (unit >> 5) & 1, b = unit >> 6;
    const long rowbase = (long)b * SEQ + blk * 128;
    LAS unsigned char* Ks = lds;
    LAS unsigned short* Vt = (LAS unsigned short*)(lds + 36864);
#pragma unroll
    for (int i = 0; i < 4; ++i) {
        const int idx = tid + i * 512, key = idx & 255, ch = idx >> 8;
        const bool valid = (blk > 0) || (key >= 128);
        u32x4 kv = (u32x4){0u, 0u, 0u, 0u}, vv = kv;
        if (valid) { const size_t r = (size_t)(rowbase - 128 + key); kv = *(const u32x4*)(P + SEC_KA + r * 128 + kvh * 64 + ch * 8); vv = *(const u32x4*)(P + SEC_VA + r * 128 + kvh * 64 + ch * 8); }
        *(LAS u32x4*)(Ks + key * 144 + ch * 16) = kv;
        LAS unsigned short* vd = Vt + (ch * 8) * 260 + key;
        vd[0 * 260] = (unsigned short)(vv.x & 0xffffu); vd[1 * 260] = (unsigned short)(vv.x >> 16);
        vd[2 * 260] = (unsigned short)(vv.y & 0xffffu); vd[3 * 260] = (unsigned short)(vv.y >> 16);
        vd[4 * 260] = (unsigned short)(vv.z & 0xffffu); vd[5 * 260] = (unsigned short)(vv.z >> 16);
        vd[6 * 260] = (unsigned short)(vv.w & 0xffffu); vd[7 * 260] = (unsigned short)(vv.w >> 16);
    }
    __syncthreads();
    const int head = kvh * 4 + (w >> 1);
    const float sink = sinks[head];
#pragma unroll 1
    for (int hf = 0; hf < 2; ++hf) {
        const int r0 = (w & 1) * 64 + hf * 32;
        const bf16_t* qptr = P + SEC_QA + (size_t)(rowbase + r0 + r32) * 512 + head * 64 + 8 * h;
        bf16x8 qf[4];
#pragma unroll
        for (int s = 0; s < 4; ++s) qf[s] = *(const bf16x8*)(qptr + 16 * s);
        f32x16 x[5];
#pragma unroll
        for (int kt = 0; kt < 5; ++kt) {
            f32x16 a0;
#pragma unroll
            for (int i = 0; i < 16; ++i) a0[i] = 0.f;
#pragma unroll
            for (int s = 0; s < 4; ++s) { const bf16x8 a = *(const LAS bf16x8*)(Ks + (r0 + kt * 32 + r32) * 144 + (16 * s + 8 * h) * 2); a0 = __builtin_amdgcn_mfma_f32_32x32x16_bf16(a, qf[s], a0, 0, 0, 0); }
            x[kt] = a0;
        }
        const int qi = r0 + r32;
        float mx = sink;
#pragma unroll
        for (int kt = 0; kt < 5; ++kt)
#pragma unroll
            for (int i = 0; i < 16; ++i) { const int f = r0 + kt * 32 + crow(i, h); const bool ok = (f > qi) && (f <= qi + 128) && ((blk > 0) || (f >= 128)); const float v = ok ? x[kt][i] : -1e30f; x[kt][i] = v; mx = fmaxf(mx, v); }
        mx = settle(mx); mx = fmaxf(mx, __shfl_xor(mx, 32));
        float l = 0.f;
#pragma unroll
        for (int kt = 0; kt < 5; ++kt)
#pragma unroll
            for (int i = 0; i < 16; ++i) { const float e = __expf(x[kt][i] - mx); x[kt][i] = e; l += e; }
        l = settle(l); l += __shfl_xor(l, 32); l += __expf(sink - mx);
        const float inv = 1.0f / l;
        f32x16 o[2];
#pragma unroll
        for (int i = 0; i < 16; ++i) { o[0][i] = 0.f; o[1][i] = 0.f; }
#pragma unroll
        for (int kt = 0; kt < 5; ++kt)
#pragma unroll
            for (int s2 = 0; s2 < 2; ++s2) {
                u32x4 pw; pw.x = pk2(x[kt][8 * s2 + 0] * inv, x[kt][8 * s2 + 1] * inv); pw.y = pk2(x[kt][8 * s2 + 2] * inv, x[kt][8 * s2 + 3] * inv);
                pw.z = pk2(x[kt][8 * s2 + 4] * inv, x[kt][8 * s2 + 5] * inv); pw.w = pk2(x[kt][8 * s2 + 6] * inv, x[kt][8 * s2 + 7] * inv);
                const bf16x8 pa = __builtin_bit_cast(bf16x8, pw);
#pragma unroll
                for (int dt = 0; dt < 2; ++dt) {
                    const LAS unsigned short* vb = Vt + (32 * dt + r32) * 260 + r0 + kt * 32 + 16 * s2 + 4 * h;
                    const s16x4 lo = *(const LAS s16x4*)vb, hi = *(const LAS s16x4*)(vb + 8);
                    const bf16x8 vf = __builtin_shufflevector(lo, hi, 0, 1, 2, 3, 4, 5, 6, 7);
                    o[dt] = __builtin_amdgcn_mfma_f32_32x32x16_bf16(pa, vf, o[dt], 0, 0, 0);
                }
            }
#pragma unroll
        for (int dt = 0; dt < 2; ++dt)
#pragma unroll
            for (int i = 0; i < 16; ++i) { const unsigned wv = pk2(o[dt][i], 0.f); P[SEC_QA + (size_t)(rowbase + r0 + crow(i, h)) * 512 + head * 64 + 32 * dt + r32] = (bf16_t)(wv & 0xffffu); }
    }
    __syncthreads();
}

__device__ __forceinline__ void scan_unit(LAS unsigned char* lds, const bf16_t* P, bf16_t* ST, int unit, int tid) {
    asm volatile("" : "+v"(tid));
    const int lane = tid & 63, w = __builtin_amdgcn_readfirstlane(tid >> 6), l15 = lane & 15, q = lane >> 4;
    const int sl = unit & 7, hh = (unit >> 3) & 3, b = unit >> 5;
    const float lg2 = log1pf(-exp2f(-5.0f - (float)hh)) * 1.4426950408889634f;
    const float cdec = ex2(128.0f * lg2);
    LAS unsigned short* Kt = (LAS unsigned short*)lds;
    LAS unsigned short* Vt = Kt + 128 * 128;
    f32x4 acc[2]; acc[0] = (f32x4){0.f, 0.f, 0.f, 0.f}; acc[1] = acc[0];
    const size_t row0 = (size_t)b * SEQ;
    const int kkey0 = tid >> 4, kch = tid & 15, vkey = tid >> 2, vch = tid & 3;
    const bf16_t* kbase = P + SEC_KR + (row0 + kkey0) * 512 + hh * 128 + kch * 8;
    const bf16_t* vbase = P + SEC_VR + (row0 + vkey) * 1024 + hh * 256 + sl * 32 + vch * 8;
    float dec[4];
#pragma unroll
    for (int i = 0; i < 4; ++i) dec[i] = ex2((float)(127 - (kkey0 + 32 * i)) * lg2);
    u32x4 kA[4], vA, kB[4], vB, kC[4], vC, kD[4], vD;
#pragma unroll
    for (int i = 0; i < 4; ++i) { kA[i] = *(const u32x4*)(kbase + (size_t)(32 * i) * 512); kB[i] = *(const u32x4*)(kbase + (size_t)(128 + 32 * i) * 512);
                                  kC[i] = *(const u32x4*)(kbase + (size_t)(256 + 32 * i) * 512); kD[i] = *(const u32x4*)(kbase + (size_t)(384 + 32 * i) * 512); }
    vA = *(const u32x4*)vbase; vB = *(const u32x4*)(vbase + (size_t)128 * 1024); vC = *(const u32x4*)(vbase + (size_t)256 * 1024); vD = *(const u32x4*)(vbase + (size_t)384 * 1024);
    int kpos[8], vpos[8];
#pragma unroll
    for (int e = 0; e < 8; ++e) { const int dk = 8 * kch + e, dv = 8 * vch + e;
        kpos[e] = dk * 128 + ((((kkey0 >> 3) ^ ((dk ^ kch) & 15)) & 15) << 3) + (kkey0 & 7);
        vpos[e] = dv * 128 + ((((vkey >> 3) ^ ((dv ^ vch) & 15)) & 15) << 3) + (vkey & 7); }
    const int rk = 16 * w + l15, gk = (rk ^ (rk >> 3)) & 15, gv0 = (l15 ^ (l15 >> 3)) & 15, gv1 = ((16 + l15) ^ ((16 + l15) >> 3)) & 15;
#define SCAN_STEP(c, KR, VR) do { \
        _Pragma("unroll") for (int tc = 0; tc < 2; ++tc) { u32x2 wv; wv.x = pk2(acc[tc][0], acc[tc][1]); wv.y = pk2(acc[tc][2], acc[tc][3]); \
            *(u32x2*)(ST + ((size_t)((b * 4 + hh) * 32 + (c)) * 256 + sl * 32 + tc * 16 + l15) * 128 + 16 * w + 4 * q) = wv; } \
        __syncthreads(); \
        _Pragma("unroll") for (int i = 0; i < 4; ++i) { const u32x4 kv = KR[i]; const float dc = dec[i]; unsigned t; \
              \
            t = pk2(pg8::bflo(kv.x) * dc, pg8::bfhi(kv.x) * dc); Kt[kpw(kpos[0], i)] = (unsigned short)(t & 0xffffu); Kt[kpw(kpos[1], i)] = (unsigned short)(t >> 16); \
            t = pk2(pg8::bflo(kv.y) * dc, pg8::bfhi(kv.y) * dc); Kt[kpw(kpos[2], i)] = (unsigned short)(t & 0xffffu); Kt[kpw(kpos[3], i)] = (unsigned short)(t >> 16); \
            t = pk2(pg8::bflo(kv.z) * dc, pg8::bfhi(kv.z) * dc); Kt[kpw(kpos[4], i)] = (unsigned short)(t & 0xffffu); Kt[kpw(kpos[5], i)] = (unsigned short)(t >> 16); \
            t = pk2(pg8::bflo(kv.w) * dc, pg8::bfhi(kv.w) * dc); Kt[kpw(kpos[6], i)] = (unsigned short)(t & 0xffffu); Kt[kpw(kpos[7], i)] = (unsigned short)(t >> 16); } \
        { Vt[vpos[0]] = (unsigned short)(VR.x & 0xffffu); Vt[vpos[1]] = (unsigned short)(VR.x >> 16); \
          Vt[vpos[2]] = (unsigned short)(VR.y & 0xffffu); Vt[vpos[3]] = (unsigned short)(VR.y >> 16); \
          Vt[vpos[4]] = (unsigned short)(VR.z & 0xffffu); Vt[vpos[5]] = (unsigned short)(VR.z >> 16); \
          Vt[vpos[6]] = (unsigned short)(VR.w & 0xffffu); Vt[vpos[7]] = (unsigned short)(VR.w >> 16); } \
        if ((c) + 4 < 32) { const size_t offr = (size_t)((c) + 4) * 128; \
            _Pragma("unroll") for (int i = 0; i < 4; ++i) KR[i] = *(const u32x4*)(kbase + (offr + 32 * i) * 512); \
            VR = *(const u32x4*)(vbase + offr * 1024); } \
        __syncthreads(); \
        acc[0] = acc[0] * cdec; acc[1] = acc[1] * cdec; \
        _Pragma("unroll") for (int s = 0; s < 4; ++s) { \
            const bf16x8 a = *(const LAS bf16x8*)(Kt + rk * 128 + (((4 * s + q) ^ gk) << 3)); \
            const bf16x8 b0 = *(const LAS bf16x8*)(Vt + l15 * 128 + (((4 * s + q) ^ gv0) << 3)); \
            const bf16x8 b1 = *(const LAS bf16x8*)(Vt + (16 + l15) * 128 + (((4 * s + q) ^ gv1) << 3)); \
            acc[0] = __builtin_amdgcn_mfma_f32_16x16x32_bf16(a, b0, acc[0], 0, 0, 0); acc[1] = __builtin_amdgcn_mfma_f32_16x16x32_bf16(a, b1, acc[1], 0, 0, 0); } \
    } while (0)
#define kpw(pos, i) ((pos) ^ ((4 * (i)) << 3))
#pragma unroll 1
    for (int c = 0; c < 32; c += 4) { SCAN_STEP(c, kA, vA); SCAN_STEP(c + 1, kB, vB); SCAN_STEP(c + 2, kC, vC); SCAN_STEP(c + 3, kD, vD); }
#undef SCAN_STEP
#undef kpw
    __syncthreads();
}

__device__ __forceinline__ void pos0_partial(LAS unsigned char* lds, const float* x, const float* gmix, const float* win, float* sx, int item, int tid) {
    const int part = item & 3, hh = (item >> 2) & 3, b = item >> 4;
    LAS float* xg = (LAS float*)(lds + 137216);
    LAS float* hp = xg + 256;
    if (tid < 256) { const int k = part * 256 + tid; xg[tid] = x[(size_t)b * SEQ * D + k] * gmix[k]; }
    __syncthreads();
    const int d2 = tid & 255, kh = tid >> 8;
    const float* wp = win + (size_t)(part * 256 + kh * 128) * PW + (d2 < 128 ? 768 + hh * 128 + d2 : 1280 + hh * 128 + (d2 - 128));
    float acc = 0.f;
#pragma unroll 32
    for (int k = 0; k < 128; ++k) acc += xg[kh * 128 + k] * wp[(size_t)k * PW];
    hp[kh * 256 + d2] = acc;
    __syncthreads();
    if (tid < 256) sx[(size_t)item * 256 + tid] = hp[tid] + hp[256 + tid];
    __syncthreads();
}

__device__ __forceinline__ void retout_unit(LAS unsigned char* lds, bf16_t* P, const bf16_t* ST, const float* gn, int unit, int tid, const float* x, const float* sx) {
    asm volatile("" : "+v"(tid));
    const int lane = tid & 63, w = __builtin_amdgcn_readfirstlane(tid >> 6), l15 = lane & 15, q = lane >> 4;
    const int c = unit & 31, hh = (unit >> 5) & 3, b = unit >> 7;
    const size_t rowc = (size_t)b * SEQ + c * 128;
    const float lg2 = log1pf(-exp2f(-5.0f - (float)hh)) * 1.4426950408889634f;
    float s_exact = 0.f;
    if (c == 0) {
        LAS float* red = (LAS float*)(lds + 137216);
        const float* xrow = x + rowc * D;
        float ssq = 0.f;
#pragma unroll
        for (int k = tid; k < 1024; k += 512) { const float xv = xrow[k]; ssq += xv * xv; }
        ssq = wave_sum(ssq); if (lane == 0) red[w] = ssq;
        if (tid < 128) { const float* sp = sx + (size_t)((b * 4 + hh) * 4) * 256 + tid;
                         const float qs = (sp[0] + sp[256]) + (sp[512] + sp[768]), ks = (sp[128] + sp[384]) + (sp[640] + sp[896]);
                         const float pr = wave_sum(qs * ks); if (lane == 0) red[8 + w] = pr; }
        __syncthreads();
        float tot = 0.f;
#pragma unroll
        for (int i = 0; i < 8; ++i) tot += red[i];
        const float rs = rsqrtf(tot * (1.0f / D) + 1e-6f);
        s_exact = (red[8] + red[9]) * rs * rs * 0.08838834764831845f;
    }
    LAS unsigned short* RA = (LAS unsigned short*)lds;
    LAS unsigned short* Ks = (LAS unsigned short*)(lds + 69632);
    const bf16_t* st = ST + (size_t)((b * 4 + hh) * 32 + c) * 32768;
    if (c != 0)
#pragma unroll
    for (int i = 0; i < 8; ++i) { const int idx = tid + i * 512, dv = idx >> 4, ch = idx & 15; *(LAS u32x4*)(RA + dv * 136 + ch * 8) = *(const u32x4*)(st + dv * 128 + ch * 8); }
#pragma unroll
    for (int i = 0; i < 4; ++i) { const int idx = tid + i * 512, key = idx >> 4, ch = idx & 15; *(LAS u32x4*)(Ks + key * 136 + ch * 8) = *(const u32x4*)(P + SEC_KR + (rowc + key) * 512 + hh * 128 + ch * 8); }
    u32x4 vreg[8];
#pragma unroll
    for (int i = 0; i < 8; ++i) { const int idx = tid + i * 512, key = idx & 127, ch = idx >> 7; vreg[i] = *(const u32x4*)(P + SEC_VR + (rowc + key) * 1024 + hh * 256 + ch * 8); }
    bf16x8 qf[4];
#pragma unroll
    for (int s = 0; s < 4; ++s) qf[s] = *(const bf16x8*)(P + SEC_QR + (rowc + 16 * w + l15) * 512 + hh * 128 + 32 * s + 8 * q);
    __syncthreads();
    f32x4 acc[16];
#pragma unroll
    for (int n = 0; n < 16; ++n) {
        f32x4 a0 = (f32x4){0.f, 0.f, 0.f, 0.f};
#pragma unroll
        for (int s = 0; s < (c == 0 ? 0 : 4); ++s) a0 = __builtin_amdgcn_mfma_f32_16x16x32_bf16(qf[s], *(const LAS bf16x8*)(RA + (16 * n + l15) * 136 + 32 * s + 8 * q), a0, 0, 0, 0);
        acc[n] = a0;
    }
    {
        f32x4 qd;
#pragma unroll
        for (int j = 0; j < 4; ++j) qd[j] = ex2((float)(16 * w + 4 * q + j + 1) * lg2);
#pragma unroll
        for (int n = 0; n < 16; ++n) acc[n] = acc[n] * qd;
    }
    f32x4 xt[8];
#pragma unroll
    for (int t = 0; t < 8; ++t) {
        f32x4 a0 = (f32x4){0.f, 0.f, 0.f, 0.f};
        if (t <= w) {
#pragma unroll
            for (int s = 0; s < 4; ++s) a0 = __builtin_amdgcn_mfma_f32_16x16x32_bf16(*(const LAS bf16x8*)(Ks + (16 * t + l15) * 136 + 32 * s + 8 * q), qf[s], a0, 0, 0, 0);
            if (t == 0 && c == 0 && w == 0 && lane == 0) a0[0] = s_exact;
#pragma unroll
            for (int j = 0; j < 4; ++j) { const int d = (16 * w + l15) - (16 * t + 4 * q + j); a0[j] = (d >= 0) ? a0[j] * ex2((float)d * lg2) : 0.f; }
        }
        xt[t] = a0;
    }
    __syncthreads();
#pragma unroll
    for (int i = 0; i < 8; ++i) { const int idx = tid + i * 512, key = idx & 127, ch = idx >> 7; LAS unsigned short* vd = RA + (ch * 8) * 132 + key; const u32x4 vv = vreg[i];
        vd[0 * 132] = (unsigned short)(vv.x & 0xffffu); vd[1 * 132] = (unsigned short)(vv.x >> 16);
        vd[2 * 132] = (unsigned short)(vv.y & 0xffffu); vd[3 * 132] = (unsigned short)(vv.y >> 16);
        vd[4 * 132] = (unsigned short)(vv.z & 0xffffu); vd[5 * 132] = (unsigned short)(vv.z >> 16);
        vd[6 * 132] = (unsigned short)(vv.w & 0xffffu); vd[7 * 132] = (unsigned short)(vv.w >> 16); }
    __syncthreads();
#pragma unroll
    for (int u = 0; u < 4; ++u) {
        if (2 * u <= w) {
            u32x4 pw; pw.x = pk2(xt[2 * u][0], xt[2 * u][1]); pw.y = pk2(xt[2 * u][2], xt[2 * u][3]); pw.z = pk2(xt[2 * u + 1][0], xt[2 * u + 1][1]); pw.w = pk2(xt[2 * u + 1][2], xt[2 * u + 1][3]);
            const bf16x8 pa = __builtin_bit_cast(bf16x8, pw);
#pragma unroll
            for (int n = 0; n < 16; ++n) {
                const LAS unsigned short* vb = RA + (16 * n + l15) * 132 + 32 * u + 4 * q;
                const s16x4 lo = *(const LAS s16x4*)vb, hi = *(const LAS s16x4*)(vb + 16);
                const bf16x8 vf = __builtin_shufflevector(lo, hi, 0, 1, 2, 3, 4, 5, 6, 7);
                acc[n] = __builtin_amdgcn_mfma_f32_16x16x32_bf16(pa, vf, acc[n], 0, 0, 0);
            }
        }
    }
    LAS unsigned short* Yw = (LAS unsigned short*)(lds + 69632) + w * (16 * 264);
    float gnv[16];
#pragma unroll
    for (int n = 0; n < 16; ++n) gnv[n] = gn[hh * 256 + 16 * n + l15];
#pragma unroll
    for (int j = 0; j < 4; ++j) {
        float s = 0.f;
#pragma unroll
        for (int n = 0; n < 16; ++n) s += acc[n][j];
        s = rsum16(s);
        const float mu = s * (1.0f / 256.0f);
        float v = 0.f;
#pragma unroll
        for (int n = 0; n < 16; ++n) { const float d = acc[n][j] - mu; v += d * d; }
        v = rsum16(v);
        const float rstd = rsqrtf(v * (1.0f / 256.0f) + 1e-6f);
#pragma unroll
        for (int n = 0; n < 16; ++n) { const float yn = (acc[n][j] - mu) * rstd * gnv[n]; Yw[(4 * q + j) * 264 + 16 * n + l15] = (unsigned short)(pk2(yn, 0.f) & 0xffffu); }
    }
    {
        u32x4 gq[8]; bf16_t* gp[8];
#pragma unroll
        for (int k = 0; k < 8; ++k) { const int id = lane + 64 * k, row = id >> 5, ch = id & 31; gp[k] = P + SEC_GR + (rowc + 16 * w + row) * 1024 + hh * 256 + ch * 8; gq[k] = *(const u32x4*)gp[k]; }
#pragma unroll
        for (int k = 0; k < 8; ++k) { const int id = lane + 64 * k, row = id >> 5, ch = id & 31;
            const u32x4 yv = *(const LAS u32x4*)(Yw + row * 264 + ch * 8); const u32x4 g = gq[k]; u32x4 o;
            o.x = pk2(pg8::bflo(yv.x) * pg8::bflo(g.x), pg8::bfhi(yv.x) * pg8::bfhi(g.x)); o.y = pk2(pg8::bflo(yv.y) * pg8::bflo(g.y), pg8::bfhi(yv.y) * pg8::bfhi(g.y));
            o.z = pk2(pg8::bflo(yv.z) * pg8::bflo(g.z), pg8::bfhi(yv.z) * pg8::bfhi(g.z)); o.w = pk2(pg8::bflo(yv.w) * pg8::bflo(g.w), pg8::bfhi(yv.w) * pg8::bfhi(g.w));
            *(u32x4*)gp[k] = o; }
    }
    __syncthreads();
}

__global__ void __launch_bounds__(NT, 2) mega(Args a) {
    extern __shared__ __attribute__((aligned(16))) unsigned char lds_raw[];
    LAS unsigned char* lds = (LAS unsigned char*)lds_raw;
    cg::grid_group grid = cg::this_grid();
    const int tid = threadIdx.x, lane = tid & 63, wave = __builtin_amdgcn_readfirstlane(tid >> 6);
    const int G = gridDim.x, bid = blockIdx.x;
    const int gw = bid * 8 + wave, NGW = G * 8;
    unsigned char* ws = a.ws;
    const float* x = a.in[0];
    bf16_t* WinT = (bf16_t*)(ws + WS_WIN); bf16_t* WattT = (bf16_t*)(ws + WS_WATT); bf16_t* WretT = (bf16_t*)(ws + WS_WRET); bf16_t* WoutT = (bf16_t*)(ws + WS_WOUT);
    bf16_t* W1T = (bf16_t*)(ws + WS_W1); bf16_t* W2T = (bf16_t*)(ws + WS_W2);
    float* tabA = (float*)(ws + WS_TABA); float* tabR = (float*)(ws + WS_TABR); float* ss1 = (float*)(ws + WS_SS1); float* ss2 = (float*)(ws + WS_SS2);
    bf16_t* XN = (bf16_t*)(ws + WS_XN); bf16_t* STATE = (bf16_t*)a.out; bf16_t* XN2 = XN;
    bf16_t* PROJ = (bf16_t*)(ws + WS_PROJ); bf16_t* HID = PROJ;
    volatile LAS unsigned* xb_st = (volatile LAS unsigned*)(lds + LDS_ST_OFF);
    if (tid < 2) xb_st[tid] = 0u;
    __syncthreads();
    if (bid == 0) { unsigned* ctl = (unsigned*)(ws + WS_CTL);
#pragma unroll
        for (int i = tid; i < (int)(CTL_BYTES / 4); i += NT) __hip_atomic_store(ctl + i, 0u, __ATOMIC_RELAXED, __HIP_MEMORY_SCOPE_AGENT); }
    asm volatile("s_waitcnt vmcnt(0)" ::: "memory");
    __syncthreads();
    grid.sync();
    const XcdBarrier xbar = xcd_barrier_post((unsigned*)(ws + WS_CTL), xb_st);
    {
        LAS float* scr = (LAS float*)(lds + wave * 16384);
        constexpr int I_IN = 16 * 184;
        for (int it = gw; it < I_IN; it += NGW) p0_transpose_item(a.in[2], 1024, 5888, WinT, scr, it, lane, true);
        const f32x4* gp = (const f32x4*)a.in[1] + lane;
        f32x4 gv[4];
#pragma unroll
        for (int j = 0; j < 4; ++j) gv[j] = gp[64 * j];
        for (int m = gw; m < M; m += 2 * NGW) {
            const int m2 = m + NGW;
            const f32x4* xr = (const f32x4*)(x + (size_t)m * D) + lane;
            const f32x4* xr2 = (const f32x4*)(x + (size_t)(m2 < M ? m2 : m) * D) + lane;
            f32x4 v[4], u[4]; float s = 0.f, s2 = 0.f;
#pragma unroll
            for (int j = 0; j < 4; ++j) { v[j] = xr[64 * j]; u[j] = xr2[64 * j]; }
#pragma unroll
            for (int j = 0; j < 4; ++j) { s += (v[j][0] * v[j][0] + v[j][1] * v[j][1]) + (v[j][2] * v[j][2] + v[j][3] * v[j][3]); s2 += (u[j][0] * u[j][0] + u[j][1] * u[j][1]) + (u[j][2] * u[j][2] + u[j][3] * u[j][3]); }
            const float rs = rsqrtf(wave_sum(s) * (1.0f / D) + 1e-6f), rs2 = rsqrtf(wave_sum(s2) * (1.0f / D) + 1e-6f);
            u32x2* o8 = (u32x2*)(XN + (size_t)m * D) + lane;
#pragma unroll
            for (int j = 0; j < 4; ++j) { u32x2 o; o.x = pk2(v[j][0] * rs * gv[j][0], v[j][1] * rs * gv[j][1]); o.y = pk2(v[j][2] * rs * gv[j][2], v[j][3] * rs * gv[j][3]); o8[64 * j] = o; }
            if (m2 < M) { u32x2* o9 = (u32x2*)(XN + (size_t)m2 * D) + lane;
#pragma unroll
                for (int j = 0; j < 4; ++j) { u32x2 o; o.x = pk2(u[j][0] * rs2 * gv[j][0], u[j][1] * rs2 * gv[j][1]); o.y = pk2(u[j][2] * rs2 * gv[j][2], u[j][3] * rs2 * gv[j][3]); o9[64 * j] = o; } }
        }
        const int gt = bid * NT + tid, NGT = G * NT;
        for (int e = gt; e < SEQ * 8; e += NGT) rope_entry(500000.0f, 16, e >> 3, e & 7, tabA + 2 * e);
        for (int e = gt; e < SEQ * 64; e += NGT) rope_entry(10000.0f, 128, e >> 6, e & 63, tabR + 2 * e);
        for (int e = gt; e < M; e += NGT) { ss1[e] = 0.f; ss2[e] = 0.f; }
    }
    XB_SYNC();
    {
        pg8::Gemm g{XN, WinT, M, PW, 1024, 1024}; pg8::StaticOrder S; S.init(M, PW, G, bid);
        pg8::EpiProj E{PROJ, a.in[3], tabA, tabR};
        pg8::gemm_phase<pg8::EpiProj, pg8::StaticOrder, true, true, 1024, 1024>(lds, g, S, E);
        {
            int nidle = 0, rank = -1;
            const int nwg = (M / 256) * (PW / 256), nr = (nwg + G - 1) / G, first_idle = nwg - (nr - 1) * G;
            if (first_idle < G) { nidle = G - first_idle; rank = bid - first_idle; } else { nidle = G; rank = bid; }
            if (rank >= 0) {
                LAS float* scr = (LAS float*)(lds + wave * 16384);
                constexpr int I_ATT = 8 * 32, I_RET = 16 * 32, I_OUT = 16 * 32, I_1 = 16 * 128, I_2 = 64 * 32, NLATE = I_ATT + I_RET + I_OUT + I_1 + I_2;
                for (int it = rank * 8 + wave; it < NLATE; it += nidle * 8) {
                    int r = it;
                    if (r < I_ATT) { p0_transpose_item(a.in[6], 512, 1024, WattT, scr, r, lane, false); continue; } r -= I_ATT;
                    if (r < I_RET) { p0_transpose_item(a.in[7], 1024, 1024, WretT, scr, r, lane, false); continue; } r -= I_RET;
                    if (r < I_OUT) { p0_transpose_item(a.in[8], 1024, 1024, WoutT, scr, r, lane, false); continue; } r -= I_OUT;
                    if (r < I_1) { p0_transpose_item(a.in[10], 1024, 4096, W1T, scr, r, lane, false); continue; } r -= I_1;
                    p0_transpose_item(a.in[11], 4096, 1024, W2T, scr, r, lane, false);
                }
                for (int it = rank; it < 128; it += nidle) pos0_partial(lds, x, a.in[1], a.in[2], (float*)(ws + WS_SX), it, tid);
            }
        }
    }
    XB_SYNC();
    {
        for (int u = bid; u < 768; u += G) {
            if (u < 256) { const int su = (G == 256) ? ((((u & 7) * 4 + ((u >> 3) >> 3)) << 3) | ((u >> 3) & 7)) : u; scan_unit(lds, PROJ, STATE, su, tid); }
            else attn_unit(lds, PROJ, a.in[4], u - 256, tid);
        }
    }
    XB_SYNC();
    for (int u = bid; u < 1024; u += G) retout_unit(lds, PROJ, STATE, a.in[5], u, tid, x, (const float*)(ws + WS_SX));
    XB_SYNC();
    {
        pg8::StaticOrder S; S.init(M, 1024, G, bid);
        { pg8::Gemm g{PROJ + SEC_QA, WattT, M, 1024, 512, 512}; pg8::EpiGateA E{PROJ}; pg8::gemm_phase<pg8::EpiGateA, pg8::StaticOrder, true, true, 512, 512>(lds, g, S, E); }
        { pg8::Gemm g{PROJ + SEC_GR, WretT, M, 1024, 1024, 1024}; pg8::EpiMerge E{PROJ}; pg8::gemm_phase<pg8::EpiMerge, pg8::StaticOrder, true, true, 1024, 1024>(lds, g, S, E); }
    }
    XB_SYNC();
    {
        pg8::StaticOrder S; S.init(M, 1024, G, bid);
        pg8::Gemm g{PROJ + SEC_GB, WoutT, M, 1024, 1024, 1024}; pg8::EpiOut E{x, a.out, XN2, a.in[9], ss1};
        pg8::gemm_phase<pg8::EpiOut, pg8::StaticOrder, true, true, 1024, 1024>(lds, g, S, E);
    }
    XB_SYNC();
    {
        pg8::StaticOrder S; S.init(M, FF, G, bid);
        pg8::Gemm g{XN2, W1T, M, FF, 1024, 1024}; pg8::EpiFF1 E{HID, ss1};
        pg8::gemm_phase<pg8::EpiFF1, pg8::StaticOrder, true, true, 1024, 1024>(lds, g, S, E);
    }
    XB_SYNC();
    {
        pg8::StaticOrder S; S.init(M, 1024, G, bid);
        pg8::Gemm g{HID, W2T, M, 1024, FF, FF}; pg8::EpiFF2 E{a.out, ss2};
        pg8::gemm_phase<pg8::EpiFF2, pg8::StaticOrder, true, true, FF, FF>(lds, g, S, E);
    }
    XB_SYNC();
    {
        int tid8 = threadIdx.x; asm volatile("" : "+v"(tid8)); int bid8 = blockIdx.x, G8 = gridDim.x; asm volatile("" : "+s"(bid8), "+s"(G8));
        const int lane = tid8 & 63, gw = bid8 * 8 + __builtin_amdgcn_readfirstlane(tid8 >> 6), NGW = G8 * 8;
        const f32x4* gp = (const f32x4*)a.in[12] + lane;
        f32x4 gv[4];
#pragma unroll
        for (int j = 0; j < 4; ++j) gv[j] = gp[64 * j];
        for (int m = gw; m < M; m += NGW) {
            const float rs = rsqrtf(ss2[m] * (1.0f / D) + 1e-6f);
            f32x4* xr = (f32x4*)(a.out + (size_t)m * D) + lane;
#pragma unroll
            for (int j = 0; j < 4; ++j) { f32x4 v = xr[64 * j]; v = v * rs * gv[j]; xr[64 * j] = v; }
        }
    }
}

extern "C" void kernel_launch(void* const* d_in, const int* in_sizes, int n_in, void* d_out, int out_size, void* d_ws, size_t ws_size, hipStream_t stream) {
    static int grid_blocks = 0;
    if (!grid_blocks) {
        if (n_in != 13 || in_sizes[0] != M * D || out_size != M * D || ws_size < WS_END) { fprintf(stderr, "kernel_launch: unexpected shapes / workspace (n_in %d, in0 %d, out %d, ws %zu)\n", n_in, n_in > 0 ? in_sizes[0] : -1, out_size, ws_size); grid_blocks = -1; return; }
        int dev = 0, cus = 0, per_cu = 0;
        hipGetDevice(&dev);
        hipDeviceGetAttribute(&cus, hipDeviceAttributeMultiprocessorCount, dev);
        hipFuncSetAttribute((const void*)mega, hipFuncAttributeMaxDynamicSharedMemorySize, LDS_BYTES);
        hipOccupancyMaxActiveBlocksPerMultiprocessor(&per_cu, (const void*)mega, NT, LDS_BYTES);
        if (per_cu < 1) { fprintf(stderr, "kernel_launch: occupancy query says %d blocks per CU\n", per_cu); per_cu = 1; }
        grid_blocks = cus;
    }
    if (grid_blocks < 0) return;
    Args a{};
    for (int i = 0; i < 13; ++i) a.in[i] = (const float*)d_in[i];
    a.out = (float*)d_out; a.ws = (unsigned char*)d_ws;
    void* args[] = {&a};
    hipError_t e = hipLaunchCooperativeKernel((void*)mega, dim3(grid_blocks), dim3(NT), args, LDS_BYTES, stream);
    if (e != hipSuccess) fprintf(stderr, "cooperative launch failed: %s (grid %d)\n", hipGetErrorString(e), grid_blocks);
}
```
